# Optimizing an MI355X kernel written in HIP

```python
import jax, jax.numpy as jnp
from jax import lax
import numpy as np

D_MODEL = 1024
BATCH = 8
SEQ = 4096
DEPTH = 2

CTX_LEN = 256
GRID_W = 64
N_MIXERS = 2
N_HEADS = 8
N_KV_HEADS = 2
HEAD_DIM = D_MODEL // N_HEADS
Q_PER_KV = N_HEADS // N_KV_HEADS
KV_WIDTH = N_KV_HEADS * HEAD_DIM
ROPE_THETA = 10000.0
Q_BLOCK = 128
N_FOURIER_GROUPS = 4
FOURIER_GROUP = D_MODEL // N_FOURIER_GROUPS
D_FF = -(-8 * D_MODEL // (3 * 256)) * 256
N_MOD = 6
N_ATTN_LAYERS = (DEPTH + 1) // 2
N_FOURIER_LAYERS = DEPTH // 2
EPS = 1e-6

kernel_name = "hybrid_attn_fourier_dit_block"


def rms_norm(x, g):
    x32 = x.astype(jnp.float32)
    y = x32 * lax.rsqrt(jnp.mean(x32 * x32, axis=-1, keepdims=True) + EPS)
    return y.astype(x.dtype) * g


def modulate(h, shift, scale):
    return h * (1 + scale) + shift


def axial_rope_angles(rows):
    row = jnp.repeat(jnp.arange(rows), GRID_W).astype(jnp.float32)
    col = jnp.tile(jnp.arange(GRID_W), rows).astype(jnp.float32)
    n_freq = HEAD_DIM // 4
    inv_freq = ROPE_THETA ** (-jnp.arange(n_freq, dtype=jnp.float32) / n_freq)
    ang = jnp.concatenate([row[:, None] * inv_freq, col[:, None] * inv_freq], axis=-1)
    return jnp.cos(ang), jnp.sin(ang)


def apply_rope(x, cos, sin):
    half = HEAD_DIM // 2
    cos = cos[None, :, None, :].astype(x.dtype)
    sin = sin[None, :, None, :].astype(x.dtype)
    x1, x2 = x[..., :half], x[..., half:]
    return jnp.concatenate([x1 * cos - x2 * sin, x1 * sin + x2 * cos], axis=-1)


def gqa_attend(q, k, v):
    s = jnp.einsum('bqkgd,bskd->bkgqs', q, k, preferred_element_type=jnp.float32) * (HEAD_DIM ** -0.5)
    p = jax.nn.softmax(s, axis=-1).astype(v.dtype)
    return jnp.einsum('bkgqs,bskd->bqkgd', p, v)


def qkv_project(h, w_qkv, g_q, g_k):
    b, n, _ = h.shape
    qkv = h @ w_qkv
    q, k, v = jnp.split(qkv, [D_MODEL, D_MODEL + KV_WIDTH], axis=-1)
    q = rms_norm(q.reshape(b, n, N_HEADS, HEAD_DIM), g_q)
    k = rms_norm(k.reshape(b, n, N_KV_HEADS, HEAD_DIM), g_k)
    v = v.reshape(b, n, N_KV_HEADS, HEAD_DIM)
    return q, k, v


def attention_mixer(hx, hc, w_qkv, g_q, g_k, w_o, cos, sin, with_ctx_queries):
    b, s, _ = hx.shape
    n_ctx = hc.shape[1]
    qx, kx, vx = qkv_project(hx, w_qkv, g_q, g_k)
    qx = apply_rope(qx, cos, sin)
    kx = apply_rope(kx, cos, sin)
    qc, kc, vc = qkv_project(hc, w_qkv, g_q, g_k)
    k_all = jnp.concatenate([kx, kc], axis=1)
    v_all = jnp.concatenate([vx, vc], axis=1)
    nb = s // Q_BLOCK
    qb = qx.reshape(b, nb, Q_BLOCK, N_KV_HEADS, Q_PER_KV, HEAD_DIM).transpose(1, 0, 2, 3, 4, 5)
    ox = lax.map(lambda q_blk: gqa_attend(q_blk, k_all, v_all), qb)
    ox = ox.transpose(1, 0, 2, 3, 4, 5).reshape(b, s, D_MODEL) @ w_o
    oc = None
    if with_ctx_queries:
        qc = qc.reshape(b, n_ctx, N_KV_HEADS, Q_PER_KV, HEAD_DIM)
        oc = gqa_attend(qc, kc, vc).reshape(b, n_ctx, D_MODEL) @ w_o
    return ox, oc


def fourier_mixer(h, w_f, b_f):
    b, n, _ = h.shape
    hg = h.astype(jnp.float32).reshape(b, n, N_FOURIER_GROUPS, FOURIER_GROUP)
    f = jnp.fft.fft2(hg, axes=(1, 3), norm='ortho').real
    return f.reshape(b, n, D_MODEL).astype(h.dtype) @ w_f + b_f


def swiglu(h, w_gate_up, w_down):
    g, u = jnp.split(h @ w_gate_up, 2, axis=-1)
    return (jax.nn.silu(g) * u) @ w_down


def setup_inputs(seed: int = 0) -> dict:
    key = jax.random.key(seed)
    ks = jax.random.split(key, 20)
    f32 = jnp.float32
    nrm = lambda k, shape, s: jax.random.normal(k, shape, f32) * s
    D = D_MODEL
    return {
        'x': nrm(ks[0], (BATCH, SEQ, D), 1.0),
        'c': nrm(ks[1], (BATCH, D), 1.0),
        'ctx': nrm(ks[2], (BATCH, CTX_LEN, D), 1.0),
        'c_ctx': nrm(ks[3], (D,), 1.0),
        'w_mod': nrm(ks[4], (DEPTH, D, N_MOD * D), 0.5 * D ** -0.5),
        'b_mod': nrm(ks[5], (DEPTH, N_MOD * D), 0.01),
        'g_mix': 1.0 + nrm(ks[6], (DEPTH, D), 0.05),
        'g_ffn': 1.0 + nrm(ks[7], (DEPTH, D), 0.05),
        'w_qkv': nrm(ks[8], (N_ATTN_LAYERS, D, D + 2 * KV_WIDTH), D ** -0.5),
        'g_q': 1.0 + nrm(ks[9], (N_ATTN_LAYERS, HEAD_DIM), 0.05),
        'g_k': 1.0 + nrm(ks[10], (N_ATTN_LAYERS, HEAD_DIM), 0.05),
        'w_attn_out': nrm(ks[11], (N_ATTN_LAYERS, D, D), D ** -0.5),
        'w_fourier': nrm(ks[12], (N_FOURIER_LAYERS, D, D), D ** -0.5),
        'b_fourier': nrm(ks[13], (N_FOURIER_LAYERS, D), 0.01),
        'w_gate_up': nrm(ks[14], (DEPTH, D, 2 * D_FF), D ** -0.5),
        'w_down': nrm(ks[15], (DEPTH, D_FF, D), D_FF ** -0.5),
        'g_final': 1.0 + nrm(ks[16], (D,), 0.05),
    }


def reference(x, c, ctx, c_ctx, w_mod, b_mod, g_mix, g_ffn, w_qkv, g_q, g_k, w_attn_out,
              w_fourier, b_fourier, w_gate_up, w_down, g_final):
    b, s, d = x.shape
    ROWS = s // GRID_W
    cos, sin = axial_rope_angles(ROWS)
    silu_c = jax.nn.silu(c)
    silu_cc = jax.nn.silu(c_ctx)
    h_ctx = ctx
    for i in range(DEPTH):
        update_ctx = i < DEPTH - 1
        is_attn = i % N_MIXERS == 0
        j = i // N_MIXERS
        mx = (silu_c @ w_mod[i] + b_mod[i]).reshape(b, N_MOD, 1, d)
        mc = (silu_cc @ w_mod[i] + b_mod[i]).reshape(N_MOD, d)
        hx = modulate(rms_norm(x, g_mix[i]), mx[:, 0], mx[:, 1])
        hc = modulate(rms_norm(h_ctx, g_mix[i]), mc[0], mc[1]) if (update_ctx or is_attn) else None
        if is_attn:
            ox, oc = attention_mixer(hx, hc, w_qkv[j], g_q[j], g_k[j], w_attn_out[j], cos, sin, update_ctx)
        else:
            ox = fourier_mixer(hx, w_fourier[j], b_fourier[j])
            oc = fourier_mixer(hc, w_fourier[j], b_fourier[j]) if update_ctx else None
        x = x + mx[:, 2] * ox
        x = x + mx[:, 5] * swiglu(modulate(rms_norm(x, g_ffn[i]), mx[:, 3], mx[:, 4]), w_gate_up[i], w_down[i])
        if update_ctx:
            h_ctx = h_ctx + mc[2] * oc
            h_ctx = h_ctx + mc[5] * swiglu(modulate(rms_norm(h_ctx, g_ffn[i]), mc[3], mc[4]), w_gate_up[i], w_down[i])
    return rms_norm(x, g_final)
```

```cpp
#include <hip/hip_runtime.h>
#include <hip/hip_cooperative_groups.h>
#include <cstdio>
#include <cstdint>
namespace cg = cooperative_groups;

#ifndef MK_COOP
#define MK_COOP 1
#endif

#define LAS __attribute__((address_space(3)))
typedef unsigned short bf16_t;
typedef short bf16x8 __attribute__((ext_vector_type(8)));
typedef short s16x4 __attribute__((ext_vector_type(4)));
typedef float f32x4 __attribute__((ext_vector_type(4)));
typedef float f32x16 __attribute__((ext_vector_type(16)));
typedef unsigned u32x4 __attribute__((ext_vector_type(4)));
typedef unsigned u32x2 __attribute__((ext_vector_type(2)));

constexpr int DM = 1024, NBATCH = 8, SEQ = 4096, CTXL = 256, DFF = 2816, NHEAD = 8, NKVH = 2, HD = 128, SKV = SEQ + CTXL;
constexpr int MTOK = NBATCH * SEQ, MCTX = NBATCH * CTXL, MALL = MTOK + MCTX, NQKV = DM + 2 * NKVH * HD;
constexpr float EPSN = 1e-6f;

constexpr size_t al256(size_t x) { return (x + 255) / 256 * 256; }
constexpr size_t WS_WQKV = 0;
constexpr size_t WS_WO   = WS_WQKV + (size_t)NQKV * DM * 2;
constexpr size_t WS_WF   = WS_WO + (size_t)DM * DM * 2;
constexpr size_t WS_WGU  = WS_WF + (size_t)DM * DM * 2;
constexpr size_t WS_WD   = WS_WGU + (size_t)2 * 2 * DFF * DM * 2;
constexpr size_t WS_CS   = WS_WD + (size_t)2 * DM * DFF * 2;
constexpr size_t WS_MOD  = WS_CS + (size_t)512 * 256 * 2;
constexpr size_t WS_ROPE = WS_MOD + (size_t)2 * 9 * 6144 * 4;
constexpr size_t WS_H    = al256(WS_ROPE + 64 * 32 * 2 * 4);
constexpr size_t WS_X    = WS_H + (size_t)MALL * DM * 2;
constexpr size_t WS_R    = WS_X + (size_t)MTOK * DM * 4;
constexpr size_t WS_Q    = WS_R;
constexpr size_t WS_K    = WS_Q + (size_t)MTOK * DM * 2;
constexpr size_t WS_V    = WS_K + (size_t)NBATCH * NKVH * SKV * HD * 2;
constexpr size_t WS_O    = WS_V + (size_t)NBATCH * NKVH * SKV * HD * 2;
constexpr size_t WS_ACT  = WS_R;
constexpr size_t WS_AP   = WS_R;
constexpr size_t WS_Z    = WS_R + (size_t)MTOK * DM * 2 * 2;
constexpr size_t WS_BAR  = WS_Z + (size_t)MTOK * DM * 2 * 2;
constexpr size_t BAR_BYTES = 16384;
constexpr size_t WS_SSQ  = WS_BAR + 16384;
constexpr size_t WS_SHW  = WS_SSQ + (size_t)MTOK * 16 * 4;
constexpr size_t WS_XG1  = WS_R + (size_t)192 * 1024 * 1024;
constexpr size_t WS_EXCH = WS_SHW + (size_t)2 * 8 * 2 * DFF * 4;
constexpr size_t WS_END  = WS_EXCH + (size_t)MTOK * 4 * 4;
static_assert(WS_XG1 >= WS_ACT + (size_t)MTOK * DFF * 2 && WS_XG1 + (size_t)MTOK * DM * 2 <= WS_BAR && WS_O + (size_t)MTOK * DM * 2 <= WS_END && WS_ACT + (size_t)MTOK * DFF * 2 <= WS_END && WS_END <= (size_t)536870912, "union region");

constexpr int STAGE_BYTES = 131072, XLDS_OFF = STAGE_BYTES, BARLDS_OFF = STAGE_BYTES + 24576, LDS_BYTES = STAGE_BYTES + 24576 + 16;

struct Params {
    const float *x, *c, *ctx, *c_ctx, *w_mod, *b_mod, *g_mix, *g_ffn, *w_qkv, *g_q, *g_k, *w_o, *w_f, *b_f, *w_gu, *w_d, *g_final;
    float* out; unsigned char* ws;
};

typedef __bf16 bf16x2_n __attribute__((ext_vector_type(2)));
typedef float f32x2_n __attribute__((ext_vector_type(2)));
__device__ __forceinline__ unsigned cvtpk(float lo, float hi) { f32x2_n v = {lo, hi}; bf16x2_n b = __builtin_convertvector(v, bf16x2_n); return *reinterpret_cast<unsigned*>(&b); }

constexpr int BM = 256, BK = 64, HALF = 128, HTB = HALF * BK * 2, NXCD = 8, WGM = 8;
__host__ __device__ __forceinline__ int lds_byte(int r, int c) { const int st = (r >> 4) * 2 + (c >> 5), rr = r & 15, cc = c & 31, ob = rr * 64 + cc * 2; return st * 1024 + (ob ^ (((ob >> 9) & 1) << 5)); }
__host__ __device__ __forceinline__ void stage_rc(int b, int& R, int& C) { const int st = b / 1024, sb = b % 1024, swz = sb ^ (((sb >> 9) & 1) << 5); R = (st >> 1) * 16 + swz / 64; C = (st & 1) * 32 + (swz % 64) / 2; }
__host__ __device__ __forceinline__ int perm32(int rho) { const int n = rho >> 4, i = rho & 15; return 8 * (i >> 2) + 4 * n + (i & 3); }

struct Unit { int pm, pn; };
__device__ __forceinline__ void tile_map(int wgid, int nM, int nN, Unit& u) {
    const int nwg = nM * nN;
    { const int q = nwg / NXCD, r = nwg % NXCD, xcd = wgid % NXCD, off = wgid / NXCD; wgid = (xcd < r ? xcd * (q + 1) : r * (q + 1) + (xcd - r) * q) + off; }
    const int nig = WGM * nN, gid = wgid / nig, fm = gid * WGM, gsz = (nM - fm) < WGM ? (nM - fm) : WGM;
    u.pm = fm + ((wgid % nig) % gsz); u.pn = (wgid % nig) / gsz;
}
struct StaticOrder {
    int nM, nN, G, c;
    __device__ __forceinline__ bool next(int i, Unit& u) const { const long L = (long)i * G + c; if (L >= (long)nM * nN) return false; tile_map((int)L, nM, nN, u); return true; }
};
struct QkvOrder {
    int G, c;
    __device__ __forceinline__ bool next(int i, Unit& u) const {
        const long L = (long)i * G + c;
        if (L < 768) { tile_map((int)L, 128, 6, u); return true; }
        if (L < 784) { const int e = (int)L - 768; u.pm = 128 + (e >> 1); u.pn = 4 + (e & 1); return true; }
        return false;
    }
};
struct ProbPlain {
    const char* A; const char* B; unsigned lda, ldb; int K;
    __device__ __forceinline__ const char* a(const Unit& u) const { return A + (size_t)u.pm * 256 * lda * 2; }
    __device__ __forceinline__ const char* b(const Unit& u) const { return B + (size_t)u.pn * 256 * ldb * 2; }
};
struct ProbCh {
    const char* A; const char* B; unsigned lda, ldb; int K;
    __device__ __forceinline__ const char* a(const Unit& u) const { return A + ((size_t)u.pm * 256 * 2048 + (size_t)u.pn * 512) * 2; }
    __device__ __forceinline__ const char* b(const Unit&) const { return B; }
};

template <class Epi, class Sched, class Prob>
__device__ __forceinline__ void gemm_phase(LAS unsigned char* lds, const Prob g, const Sched& S, const Epi& E) {
    const int tid = threadIdx.x, wid = __builtin_amdgcn_readfirstlane(tid >> 6), lane = tid & 63, wr = wid >> 2, wc = wid & 3, fr = lane & 15, fq = lane >> 4;
    const int nt = g.K / BK;
    unsigned voffA[2], voffB[2];
#pragma unroll
    for (int i = 0; i < 2; ++i) { int R, C; stage_rc(tid * 16 + i * 8192, R, C); const int Rb = Epi::PERM ? ((R & ~31) + perm32(R & 31)) : R;
        voffA[i] = (unsigned)(R * g.lda + C) * 2u; voffB[i] = (unsigned)(Rb * g.ldb + C) * 2u; }
    const size_t kstep = (size_t)(BK * 2);
    const size_t hstepA = (size_t)HALF * g.lda * 2, hstepB = (size_t)HALF * g.ldb * 2;
    const unsigned ldsw = (unsigned)wid * 1024u;
    const int aoff = lds_byte(wr * 64 + fr, fq * 8), boff = lds_byte(wc * 32 + fr, fq * 8);
    LAS float* xlds = (LAS float*)(lds + XLDS_OFF);
#define PG8_SA(b, h) (((b) * 2 + (h)) * HTB)
#define PG8_SB(b, h) ((4 + (b) * 2 + (h)) * HTB)
#define PG8_STAGE(bufoff, gbase, voff) do { _Pragma("unroll") for (int _i = 0; _i < 2; ++_i) \
        __builtin_amdgcn_global_load_lds((const unsigned*)((const char*)(gbase) + (voff)[_i]), (LAS unsigned*)(lds + (bufoff) + ldsw + _i * 8192), 16, 0, 0); } while (0)
#define PG8_LDA(dst, b, h) do { _Pragma("unroll") for (int m = 0; m < 4; ++m) _Pragma("unroll") for (int k = 0; k < 2; ++k) dst[m][k] = *(const LAS bf16x8*)(lds + PG8_SA(b, h) + aoff + m * 2048 + k * 1024); } while (0)
#define PG8_LDB(dst, b, h) do { _Pragma("unroll") for (int n = 0; n < 2; ++n) _Pragma("unroll") for (int k = 0; k < 2; ++k) dst[n][k] = *(const LAS bf16x8*)(lds + PG8_SB(b, h) + boff + n * 2048 + k * 1024); } while (0)
#define PG8_MMA(ai, bj, At, Bt) do { __builtin_amdgcn_s_setprio(1); _Pragma("unroll") for (int m = 0; m < 4; ++m) _Pragma("unroll") for (int n = 0; n < 2; ++n) _Pragma("unroll") for (int k = 0; k < 2; ++k) \
        acc[ai][bj][m][n] = __builtin_amdgcn_mfma_f32_16x16x32_bf16(Bt[n][k], At[m][k], acc[ai][bj][m][n], 0, 0, 0); __builtin_amdgcn_s_setprio(0); } while (0)
#define PG8_WAIT_V(n) asm volatile("s_waitcnt vmcnt(" #n ")" ::: "memory")
#define PG8_WAIT_L(n) asm volatile("s_waitcnt lgkmcnt(" #n ")" ::: "memory")
#define PG8_BAR __builtin_amdgcn_s_barrier()
#define PG8_SCHED __builtin_amdgcn_sched_barrier(0)
    Unit cur, nxt; int ui = 0;
    if (!S.next(0, cur)) return;
    f32x4 acc[2][2][4][2];
#pragma unroll
    for (int a = 0; a < 2; ++a)
#pragma unroll
        for (int b = 0; b < 2; ++b)
#pragma unroll
            for (int m = 0; m < 4; ++m)
#pragma unroll
                for (int n = 0; n < 2; ++n) acc[a][b][m][n] = (f32x4){0.f, 0.f, 0.f, 0.f};
    bf16x8 At[4][2], B0[2][2], B1[2][2];
    const char* cA = g.a(cur); const char* cB = g.b(cur);
    PG8_STAGE(PG8_SB(0, 0), cB, voffB); PG8_STAGE(PG8_SB(0, 1), cB + hstepB, voffB); PG8_STAGE(PG8_SA(0, 0), cA, voffA); PG8_STAGE(PG8_SA(0, 1), cA + hstepA, voffA);
    if (wr == 1) PG8_BAR;
    PG8_WAIT_V(2); PG8_BAR;
    PG8_STAGE(PG8_SB(1, 0), cB + kstep, voffB); PG8_STAGE(PG8_SA(1, 0), cA + kstep, voffA); PG8_STAGE(PG8_SB(1, 1), cB + hstepB + kstep, voffB);
    PG8_WAIT_V(6); PG8_BAR;
    for (;;) {
        const bool has_next = S.next(ui + 1, nxt);
        const char* nA = has_next ? g.a(nxt) : cA; const char* nB = has_next ? g.b(nxt) : cB;
#pragma unroll 1
        for (int t = 0; t < nt; t += 2) {
            const bool last = (t == nt - 2);
            const char* a1 = cA + (size_t)(t + 1) * kstep;
            const char* a2 = last ? nA : cA + (size_t)(t + 2) * kstep; const char* b2 = last ? nB : cB + (size_t)(t + 2) * kstep;
            const char* a3 = a2 + kstep; const char* b3 = b2 + kstep;
            PG8_LDB(B0, 0, 0); PG8_LDB(B1, 0, 1); PG8_SCHED; PG8_LDA(At, 0, 0); PG8_STAGE(PG8_SA(1, 1), a1 + hstepA, voffA);
            PG8_WAIT_V(8); PG8_WAIT_L(0); PG8_BAR; PG8_MMA(0, 0, At, B0); PG8_MMA(0, 1, At, B1); PG8_BAR; PG8_SCHED;
            PG8_LDA(At, 0, 1); PG8_STAGE(PG8_SB(0, 0), b2, voffB); PG8_STAGE(PG8_SB(0, 1), b2 + hstepB, voffB); PG8_STAGE(PG8_SA(0, 0), a2, voffA);
            PG8_WAIT_V(8); PG8_WAIT_L(0); PG8_BAR; PG8_MMA(1, 0, At, B0); PG8_MMA(1, 1, At, B1); PG8_BAR; PG8_SCHED;
            PG8_LDB(B0, 1, 0); PG8_LDB(B1, 1, 1); PG8_SCHED; PG8_LDA(At, 1, 0); PG8_STAGE(PG8_SA(0, 1), a2 + hstepA, voffA);
            PG8_WAIT_V(8); PG8_WAIT_L(0); PG8_BAR; PG8_MMA(0, 0, At, B0); PG8_MMA(0, 1, At, B1); PG8_BAR; PG8_SCHED;
            PG8_LDA(At, 1, 1); PG8_STAGE(PG8_SB(1, 0), b3, voffB); PG8_STAGE(PG8_SB(1, 1), b3 + hstepB, voffB); PG8_STAGE(PG8_SA(1, 0), a3, voffA);
            PG8_WAIT_V(8); PG8_WAIT_L(0); PG8_BAR; PG8_MMA(1, 0, At, B0); PG8_MMA(1, 1, At, B1); PG8_BAR; PG8_SCHED;
        }
        if (wr == 0) PG8_BAR;
        E(acc, cur, wr, wc, fr, fq, xlds, ui);
        if (!has_next) break;
#pragma unroll
        for (int a = 0; a < 2; ++a)
#pragma unroll
            for (int b = 0; b < 2; ++b)
#pragma unroll
                for (int m = 0; m < 4; ++m)
#pragma unroll
                    for (int n = 0; n < 2; ++n) acc[a][b][m][n] = (f32x4){0.f, 0.f, 0.f, 0.f};
        cur = nxt; cA = nA; cB = nB; ++ui;
        if (wr == 1) PG8_BAR;
    }
    PG8_WAIT_V(0);
    PG8_BAR;
#undef PG8_SA
#undef PG8_SB
#undef PG8_STAGE
#undef PG8_LDA
#undef PG8_LDB
#undef PG8_MMA
#undef PG8_WAIT_V
#undef PG8_WAIT_L
#undef PG8_BAR
#undef PG8_SCHED
}

struct EpiResid {
    static constexpr bool PERM = false;
    const float* xin; float* xout; const float* gate; const float* bias;
    __device__ __forceinline__ void operator()(const f32x4 (&acc)[2][2][4][2], const Unit& u, int wr, int wc, int fr, int fq, LAS float*, int) const {
        const int row0 = u.pm * BM + wr * 64 + fr, col0 = u.pn * BM + wc * 32 + 4 * fq;
        const float* gp = gate + (size_t)((u.pm * BM) >> 12) * 6144 + col0;
        f32x4 gv[2][2], bv[2][2];
#pragma unroll
        for (int bj = 0; bj < 2; ++bj)
#pragma unroll
            for (int n = 0; n < 2; ++n) { gv[bj][n] = *(const f32x4*)(gp + bj * HALF + n * 16); bv[bj][n] = bias ? *(const f32x4*)(bias + col0 + bj * HALF + n * 16) : (f32x4){0.f, 0.f, 0.f, 0.f}; }
#pragma unroll
        for (int ai = 0; ai < 2; ++ai)
#pragma unroll
            for (int m = 0; m < 4; ++m) { const size_t off = (size_t)(row0 + ai * HALF + m * 16) * DM + col0;
#pragma unroll
                for (int bj = 0; bj < 2; ++bj)
#pragma unroll
                    for (int n = 0; n < 2; ++n) { const f32x4 xv = *(const f32x4*)(xin + off + bj * HALF + n * 16);
                        *(f32x4*)(xout + off + bj * HALF + n * 16) = xv + gv[bj][n] * (acc[ai][bj][m][n] + bv[bj][n]); } }
    }
};
__device__ __forceinline__ float silu_f(float g) { return g * __builtin_amdgcn_rcpf(1.0f + __expf(-g)); }
struct EpiSwiGLU {
    static constexpr bool PERM = true;
    bf16_t* act;
    __device__ __forceinline__ void operator()(const f32x4 (&acc)[2][2][4][2], const Unit& u, int wr, int wc, int fr, int fq, LAS float*, int) const {
        const int row0 = u.pm * BM + wr * 64 + fr, col0 = u.pn * HALF + wc * 32 + 8 * fq;
#pragma unroll
        for (int ai = 0; ai < 2; ++ai)
#pragma unroll
            for (int m = 0; m < 4; ++m) {
                const f32x4 g0 = acc[ai][0][m][0], g1 = acc[ai][0][m][1], u0 = acc[ai][1][m][0], u1 = acc[ai][1][m][1];
                u32x4 w; w.x = cvtpk(silu_f(g0[0]) * u0[0], silu_f(g0[1]) * u0[1]); w.y = cvtpk(silu_f(g0[2]) * u0[2], silu_f(g0[3]) * u0[3]);
                w.z = cvtpk(silu_f(g1[0]) * u1[0], silu_f(g1[1]) * u1[1]); w.w = cvtpk(silu_f(g1[2]) * u1[2], silu_f(g1[3]) * u1[3]);
                *(u32x4*)(act + (size_t)(row0 + ai * HALF + m * 16) * DFF + col0) = w; }
    }
};
struct EpiResidXg {
    static constexpr bool PERM = false;
    const float* xin; float* xout; const float* gate; const float* bias; bf16_t* xg; float* ssq; const float* gnext; const float* scale;
    __device__ __forceinline__ void operator()(const f32x4 (&acc)[2][2][4][2], const Unit& u, int wr, int wc, int fr, int fq, LAS float*, int) const {
        const int row0 = u.pm * BM + wr * 64 + fr, col0 = u.pn * BM + wc * 32 + 4 * fq, b = (u.pm * BM) >> 12;
        const float* gp = gate + (size_t)b * 6144 + col0; const float* sp = scale + (size_t)b * 6144 + col0;
        f32x4 gv[2][2], bv[2][2], gs[2][2];
#pragma unroll
        for (int bj = 0; bj < 2; ++bj)
#pragma unroll
            for (int n = 0; n < 2; ++n) { gv[bj][n] = *(const f32x4*)(gp + bj * HALF + n * 16); bv[bj][n] = bias ? *(const f32x4*)(bias + col0 + bj * HALF + n * 16) : (f32x4){0.f, 0.f, 0.f, 0.f};
                gs[bj][n] = *(const f32x4*)(gnext + col0 + bj * HALF + n * 16) * (*(const f32x4*)(sp + bj * HALF + n * 16) + 1.0f); }
#pragma unroll
        for (int ai = 0; ai < 2; ++ai)
#pragma unroll
            for (int m = 0; m < 4; ++m) { const int row = row0 + ai * HALF + m * 16; const size_t off = (size_t)row * DM + col0; float s = 0.f;
#pragma unroll
                for (int bj = 0; bj < 2; ++bj)
#pragma unroll
                    for (int n = 0; n < 2; ++n) { const f32x4 xv = *(const f32x4*)(xin + off + bj * HALF + n * 16);
                        const f32x4 y = xv + gv[bj][n] * (acc[ai][bj][m][n] + bv[bj][n]);
                        *(f32x4*)(xout + off + bj * HALF + n * 16) = y;
                        s += (y[0] * y[0] + y[1] * y[1]) + (y[2] * y[2] + y[3] * y[3]);
                        const f32x4 z = y * gs[bj][n]; u32x2 w; w.x = cvtpk(z[0], z[1]); w.y = cvtpk(z[2], z[3]);
                        *(u32x2*)(xg + off + bj * HALF + n * 16) = w; }
                s += __shfl_xor(s, 16); s += __shfl_xor(s, 32);
                if (fq == 0) ssq[(size_t)row * 16 + u.pn * 4 + wc] = s; }
    }
};
struct EpiResidLast {
    static constexpr bool PERM = false;
    const float* xin; const float* gate; bf16_t* xb; float* ssq;
    __device__ __forceinline__ void operator()(const f32x4 (&acc)[2][2][4][2], const Unit& u, int wr, int wc, int fr, int fq, LAS float*, int) const {
        const int row0 = u.pm * BM + wr * 64 + fr, col0 = u.pn * BM + wc * 32 + 4 * fq;
        const float* gp = gate + (size_t)((u.pm * BM) >> 12) * 6144 + col0;
        f32x4 gv[2][2];
#pragma unroll
        for (int bj = 0; bj < 2; ++bj)
#pragma unroll
            for (int n = 0; n < 2; ++n) gv[bj][n] = *(const f32x4*)(gp + bj * HALF + n * 16);
#pragma unroll
        for (int ai = 0; ai < 2; ++ai)
#pragma unroll
            for (int m = 0; m < 4; ++m) { const int row = row0 + ai * HALF + m * 16; const size_t off = (size_t)row * DM + col0; float s = 0.f;
#pragma unroll
                for (int bj = 0; bj < 2; ++bj)
#pragma unroll
                    for (int n = 0; n < 2; ++n) { const f32x4 xv = *(const f32x4*)(xin + off + bj * HALF + n * 16);
                        const f32x4 y = xv + gv[bj][n] * acc[ai][bj][m][n];
                        s += (y[0] * y[0] + y[1] * y[1]) + (y[2] * y[2] + y[3] * y[3]);
                        u32x2 w; w.x = cvtpk(y[0], y[1]); w.y = cvtpk(y[2], y[3]);
                        *(u32x2*)(xb + off + bj * HALF + n * 16) = w; }
                s += __shfl_xor(s, 16); s += __shfl_xor(s, 32);
                if (fq == 0) ssq[(size_t)row * 16 + u.pn * 4 + wc] = s; }
    }
};
template <bool XIN_F32> struct EpiResB {
    static constexpr bool PERM = true;
    const void* xin; bf16_t* xout; const float* gate; const float* bias; bf16_t* xg; float* ssq; const float* gnext; const float* scale;
    __device__ __forceinline__ void operator()(const f32x4 (&acc)[2][2][4][2], const Unit& u, int wr, int wc, int fr, int fq, LAS float*, int) const {
        const int row0 = u.pm * BM + wr * 64 + fr, col0 = u.pn * BM + wc * 32 + 8 * fq, b = (u.pm * BM) >> 12;
        const float* gp = gate + (size_t)b * 6144 + col0;
        f32x4 gv[2][2], bv[2][2], gs[2][2];
#pragma unroll
        for (int bj = 0; bj < 2; ++bj)
#pragma unroll
            for (int n = 0; n < 2; ++n) { gv[bj][n] = *(const f32x4*)(gp + bj * HALF + n * 4); bv[bj][n] = bias ? *(const f32x4*)(bias + col0 + bj * HALF + n * 4) : (f32x4){0.f, 0.f, 0.f, 0.f};
                gs[bj][n] = xg ? *(const f32x4*)(gnext + col0 + bj * HALF + n * 4) * (*(const f32x4*)(scale + (size_t)b * 6144 + col0 + bj * HALF + n * 4) + 1.0f) : (f32x4){0.f, 0.f, 0.f, 0.f}; }
#pragma unroll
        for (int ai = 0; ai < 2; ++ai)
#pragma unroll
            for (int m = 0; m < 4; ++m) { const int row = row0 + ai * HALF + m * 16; const size_t off = (size_t)row * DM + col0; float s = 0.f;
#pragma unroll
                for (int bj = 0; bj < 2; ++bj) { f32x4 x0, x1;
                    if (XIN_F32) { const float* xp = (const float*)xin + off + bj * HALF; x0 = *(const f32x4*)xp; x1 = *(const f32x4*)(xp + 4); }
                    else { const u32x4 r = *(const u32x4*)((const bf16_t*)xin + off + bj * HALF);
                        x0 = (f32x4){__uint_as_float(r[0] << 16), __uint_as_float(r[0] & 0xffff0000u), __uint_as_float(r[1] << 16), __uint_as_float(r[1] & 0xffff0000u)};
                        x1 = (f32x4){__uint_as_float(r[2] << 16), __uint_as_float(r[2] & 0xffff0000u), __uint_as_float(r[3] << 16), __uint_as_float(r[3] & 0xffff0000u)}; }
                    const f32x4 y0 = x0 + gv[bj][0] * (acc[ai][bj][m][0] + bv[bj][0]), y1 = x1 + gv[bj][1] * (acc[ai][bj][m][1] + bv[bj][1]);
                    s += ((y0[0] * y0[0] + y0[1] * y0[1]) + (y0[2] * y0[2] + y0[3] * y0[3])) + ((y1[0] * y1[0] + y1[1] * y1[1]) + (y1[2] * y1[2] + y1[3] * y1[3]));
                    u32x4 w; w.x = cvtpk(y0[0], y0[1]); w.y = cvtpk(y0[2], y0[3]); w.z = cvtpk(y1[0], y1[1]); w.w = cvtpk(y1[2], y1[3]);
                    *(u32x4*)(xout + off + bj * HALF) = w;
                    if (xg) { const f32x4 z0 = y0 * gs[bj][0], z1 = y1 * gs[bj][1];
                        u32x4 v; v.x = cvtpk(z0[0], z0[1]); v.y = cvtpk(z0[2], z0[3]); v.z = cvtpk(z1[0], z1[1]); v.w = cvtpk(z1[2], z1[3]);
                        *(u32x4*)(xg + off + bj * HALF) = v; } }
                if (ssq) { s += __shfl_xor(s, 16); s += __shfl_xor(s, 32);
                    if (fq == 0) ssq[(size_t)row * 16 + u.pn * 4 + wc] = s; } }
    }
};
struct EpiFinal {
    static constexpr bool PERM = true;
    const bf16_t* xin; const float* gate; const float* gfin; float* out; float* exch; unsigned* cnt;
    __device__ __forceinline__ void operator()(const f32x4 (&acc)[2][2][4][2], const Unit& u, int wr, int wc, int fr, int fq, LAS float* xs, int) const {
        const int rl0 = wr * 64 + fr, col0 = u.pn * BM + wc * 32 + 8 * fq, b = (u.pm * BM) >> 12, t = threadIdx.x;
        const float* gp = gate + (size_t)b * 6144 + col0;
        f32x4 gv[2][2];
#pragma unroll
        for (int bj = 0; bj < 2; ++bj)
#pragma unroll
            for (int n = 0; n < 2; ++n) gv[bj][n] = *(const f32x4*)(gp + bj * HALF + n * 4);
        f32x4 y[2][4][2][2];
#pragma unroll
        for (int ai = 0; ai < 2; ++ai)
#pragma unroll
            for (int m = 0; m < 4; ++m) { const int rl = ai * HALF + rl0 + m * 16; const size_t off = (size_t)(u.pm * BM + rl) * DM + col0; float s = 0.f;
#pragma unroll
                for (int bj = 0; bj < 2; ++bj) { const u32x4 r = *(const u32x4*)(xin + off + bj * HALF);
                    const f32x4 x0 = (f32x4){__uint_as_float(r[0] << 16), __uint_as_float(r[0] & 0xffff0000u), __uint_as_float(r[1] << 16), __uint_as_float(r[1] & 0xffff0000u)};
                    const f32x4 x1 = (f32x4){__uint_as_float(r[2] << 16), __uint_as_float(r[2] & 0xffff0000u), __uint_as_float(r[3] << 16), __uint_as_float(r[3] & 0xffff0000u)};
                    const f32x4 y0 = x0 + gv[bj][0] * acc[ai][bj][m][0], y1 = x1 + gv[bj][1] * acc[ai][bj][m][1];
                    y[ai][m][bj][0] = y0; y[ai][m][bj][1] = y1;
                    s += ((y0[0] * y0[0] + y0[1] * y0[1]) + (y0[2] * y0[2] + y0[3] * y0[3])) + ((y1[0] * y1[0] + y1[1] * y1[1]) + (y1[2] * y1[2] + y1[3] * y1[3])); }
                s += __shfl_xor(s, 16); s += __shfl_xor(s, 32);
                if (fq == 0) xs[rl * 4 + wc] = s; }
        asm volatile("s_waitcnt lgkmcnt(0)" ::: "memory"); __builtin_amdgcn_s_barrier(); asm volatile("" ::: "memory");
        if (t < 256) { const f32x4 pr = *(const LAS f32x4*)(xs + t * 4);
            __hip_atomic_store(exch + ((size_t)u.pm * BM + t) * 4 + u.pn, (pr[0] + pr[1]) + (pr[2] + pr[3]), __ATOMIC_RELAXED, __HIP_MEMORY_SCOPE_AGENT); }
        asm volatile("s_waitcnt vmcnt(0)" ::: "memory"); __builtin_amdgcn_s_barrier(); asm volatile("" ::: "memory");
        if (t == 0) { unsigned* cp = cnt + u.pm * 4;
            __builtin_amdgcn_fence(__ATOMIC_RELEASE, "agent");
            (void)__hip_atomic_fetch_add(cp, 1u, __ATOMIC_RELAXED, __HIP_MEMORY_SCOPE_AGENT);
            unsigned sp = 0u;
            while (__hip_atomic_load(cp, __ATOMIC_RELAXED, __HIP_MEMORY_SCOPE_AGENT) < 4u) { __builtin_amdgcn_s_sleep(1); if (++sp > (1u << 22)) break; }
            __builtin_amdgcn_fence(__ATOMIC_ACQUIRE, "agent");
            asm volatile("s_waitcnt vmcnt(0)" ::: "memory"); }
        __builtin_amdgcn_s_barrier(); asm volatile("" ::: "memory");
        if (t < 256) { const float* ep = exch + ((size_t)u.pm * BM + t) * 4; float tot = 0.f;
#pragma unroll
            for (int q = 0; q < 4; ++q) tot += __hip_atomic_load(ep + q, __ATOMIC_RELAXED, __HIP_MEMORY_SCOPE_AGENT);
            xs[1024 + t] = __builtin_amdgcn_rsqf(tot * (1.0f / DM) + EPSN); }
        asm volatile("s_waitcnt lgkmcnt(0)" ::: "memory"); __builtin_amdgcn_s_barrier(); asm volatile("" ::: "memory");
        f32x4 gf[2][2];
#pragma unroll
        for (int bj = 0; bj < 2; ++bj)
#pragma unroll
            for (int n = 0; n < 2; ++n) gf[bj][n] = *(const f32x4*)(gfin + col0 + bj * HALF + n * 4);
#pragma unroll
        for (int ai = 0; ai < 2; ++ai)
#pragma unroll
            for (int m = 0; m < 4; ++m) { const int rl = ai * HALF + rl0 + m * 16; const float rs = xs[1024 + rl]; float* op = out + (size_t)(u.pm * BM + rl) * DM + col0;
#pragma unroll
                for (int bj = 0; bj < 2; ++bj) { *(f32x4*)(op + bj * HALF) = y[ai][m][bj][0] * rs * gf[bj][0]; *(f32x4*)(op + bj * HALF + 4) = y[ai][m][bj][1] * rs * gf[bj][1]; } }
    }
};
struct EpiSwiGLU2 {
    static constexpr bool PERM = true;
    bf16_t* act; const float* ssq; const float* shw;
    __device__ __forceinline__ void operator()(const f32x4 (&acc)[2][2][4][2], const Unit& u, int wr, int wc, int fr, int fq, LAS float* xs, int ui) const {
        xs += ui * 256;
        const int rl0 = wr * 64 + fr, row0 = u.pm * BM + rl0, col0 = u.pn * HALF + wc * 32 + 8 * fq, b = (u.pm * BM) >> 12;
        const LAS float* sw = xs + 3072 + wc * 32 + 8 * fq;
        const f32x4 sg0 = *(const LAS f32x4*)sw, sg1 = *(const LAS f32x4*)(sw + 4), su0 = *(const LAS f32x4*)(sw + HALF), su1 = *(const LAS f32x4*)(sw + HALF + 4);
#pragma unroll
        for (int ai = 0; ai < 2; ++ai)
#pragma unroll
            for (int m = 0; m < 4; ++m) { const float rs = xs[ai * HALF + rl0 + m * 16];
                const f32x4 g0 = acc[ai][0][m][0] * rs + sg0, g1 = acc[ai][0][m][1] * rs + sg1, u0 = acc[ai][1][m][0] * rs + su0, u1 = acc[ai][1][m][1] * rs + su1;
                u32x4 w; w.x = cvtpk(silu_f(g0[0]) * u0[0], silu_f(g0[1]) * u0[1]); w.y = cvtpk(silu_f(g0[2]) * u0[2], silu_f(g0[3]) * u0[3]);
                w.z = cvtpk(silu_f(g1[0]) * u1[0], silu_f(g1[1]) * u1[1]); w.w = cvtpk(silu_f(g1[2]) * u1[2], silu_f(g1[3]) * u1[3]);
                *(u32x4*)(act + (size_t)(row0 + ai * HALF + m * 16) * DFF + col0) = w; }
    }
};
struct EpiBf16 {
    static constexpr bool PERM = true;
    bf16_t* O;
    __device__ __forceinline__ void operator()(const f32x4 (&acc)[2][2][4][2], const Unit& u, int wr, int wc, int fr, int fq, LAS float*, int) const {
        const int row0 = u.pm * BM + wr * 64 + fr, col0 = u.pn * BM + wc * 32 + 8 * fq;
#pragma unroll
        for (int ai = 0; ai < 2; ++ai)
#pragma unroll
            for (int m = 0; m < 4; ++m) { bf16_t* rowp = O + (size_t)(row0 + ai * HALF + m * 16) * DM + col0;
#pragma unroll
                for (int bj = 0; bj < 2; ++bj) { const f32x4 v0 = acc[ai][bj][m][0], v1 = acc[ai][bj][m][1];
                    u32x4 w; w.x = cvtpk(v0[0], v0[1]); w.y = cvtpk(v0[2], v0[3]); w.z = cvtpk(v1[0], v1[1]); w.w = cvtpk(v1[2], v1[3]);
                    *(u32x4*)(rowp + bj * HALF) = w; } }
    }
};
struct EpiQKV {
    static constexpr bool PERM = true;
    bf16_t* Q; bf16_t* Kc; bf16_t* Vc; const float* gq; const float* gk; const float* rope;
    __device__ __forceinline__ void operator()(const f32x4 (&acc)[2][2][4][2], const Unit& u, int wr, int wc, int fr, int fq, LAS float* xs, int ui) const {
        const int rl0 = wr * 64 + fr, cl = wc * 32 + 8 * fq;
        if (u.pn == 5) {
#pragma unroll
            for (int ai = 0; ai < 2; ++ai)
#pragma unroll
                for (int m = 0; m < 4; ++m) { const int R = u.pm * BM + ai * HALF + rl0 + m * 16; int b, pos;
                    if (R < MTOK) { b = R >> 12; pos = R & 4095; } else { const int r2 = R - MTOK; b = r2 >> 8; pos = SEQ + (r2 & 255); }
#pragma unroll
                    for (int bj = 0; bj < 2; ++bj) { const f32x4 v0 = acc[ai][bj][m][0], v1 = acc[ai][bj][m][1];
                        u32x4 w; w.x = cvtpk(v0[0], v0[1]); w.y = cvtpk(v0[2], v0[3]); w.z = cvtpk(v1[0], v1[1]); w.w = cvtpk(v1[2], v1[3]);
                        *(u32x4*)(Vc + ((size_t)(b * NKVH + bj) * SKV + pos) * HD + cl) = w; } }
            return;
        }
        const bool isk = (u.pn == 4);
#pragma unroll
        for (int ai = 0; ai < 2; ++ai)
#pragma unroll
            for (int m = 0; m < 4; ++m)
#pragma unroll
                for (int bj = 0; bj < 2; ++bj) { const f32x4 v0 = acc[ai][bj][m][0], v1 = acc[ai][bj][m][1];
                    float s = (v0[0] * v0[0] + v0[1] * v0[1]) + (v0[2] * v0[2] + v0[3] * v0[3]) + (v1[0] * v1[0] + v1[1] * v1[1]) + (v1[2] * v1[2] + v1[3] * v1[3]);
                    s += __shfl_xor(s, 16); s += __shfl_xor(s, 32);
                    if (fq == 0) xs[((ai * HALF + rl0 + m * 16) * 2 + bj) * 4 + wc] = s; }
        asm volatile("s_waitcnt lgkmcnt(0)" ::: "memory"); __builtin_amdgcn_s_barrier(); asm volatile("" ::: "memory");
        const float* g = isk ? gk : gq;
        const int p0 = 16 * wc + 4 * fq;
        const f32x4 ga = *(const f32x4*)(g + p0), gb = *(const f32x4*)(g + 64 + p0);
#pragma unroll
        for (int ai = 0; ai < 2; ++ai)
#pragma unroll
            for (int m = 0; m < 4; ++m) { const int rl = ai * HALF + rl0 + m * 16, R = u.pm * BM + rl; int b, pos; bool isctx = false;
                if (R < MTOK) { b = R >> 12; pos = R & 4095; } else { const int r2 = R - MTOK; b = r2 >> 8; pos = SEQ + (r2 & 255); isctx = true; }
                f32x4 t0 = (f32x4){1.f, 0.f, 1.f, 0.f}, t1 = (f32x4){1.f, 0.f, 1.f, 0.f};
                if (!isctx) { const int pp = (wc < 2) ? (pos >> 6) : (pos & 63); const float* tp = rope + ((size_t)pp * 32 + (p0 & 31)) * 2;
                    t0 = *(const f32x4*)tp; t1 = *(const f32x4*)(tp + 4); }
#pragma unroll
                for (int bj = 0; bj < 2; ++bj) {
                    const f32x4 part = *(const LAS f32x4*)(xs + (rl * 2 + bj) * 4);
                    const float rstd = __builtin_amdgcn_rsqf(((part[0] + part[1]) + (part[2] + part[3])) * (1.0f / 128.0f) + EPSN);
                    const f32x4 v0 = acc[ai][bj][m][0], v1 = acc[ai][bj][m][1];
                    const float a0 = v0[0] * rstd * ga[0], b0 = v0[1] * rstd * gb[0], a1 = v0[2] * rstd * ga[1], b1 = v0[3] * rstd * gb[1];
                    const float a2 = v1[0] * rstd * ga[2], b2 = v1[1] * rstd * gb[2], a3 = v1[2] * rstd * ga[3], b3 = v1[3] * rstd * gb[3];
                    u32x4 w;
                    w.x = cvtpk(a0 * t0[0] - b0 * t0[1], a0 * t0[1] + b0 * t0[0]); w.y = cvtpk(a1 * t0[2] - b1 * t0[3], a1 * t0[3] + b1 * t0[2]);
                    w.z = cvtpk(a2 * t1[0] - b2 * t1[1], a2 * t1[1] + b2 * t1[0]); w.w = cvtpk(a3 * t1[2] - b3 * t1[3], a3 * t1[3] + b3 * t1[2]);
                    bf16_t* dst = isk ? (Kc + ((size_t)(b * NKVH + bj) * SKV + pos) * HD + cl) : (Q + (size_t)R * DM + (2 * u.pn + bj) * HD + cl);
                    *(u32x4*)dst = w; }
                __builtin_amdgcn_sched_barrier(0); }
    }
};

template <class Sched> __device__ __forceinline__ void rstd_prestep(const Sched& S, const float* __restrict__ ssq, const float* __restrict__ shw, LAS float* xs) {
    const int t = threadIdx.x, rowl = t >> 1, half = t & 1;
#pragma unroll 1
    for (int i = 0; i < 12; ++i) { Unit u; if (!S.next(i, u)) break;
        const float* pp = ssq + (size_t)(u.pm * BM + rowl) * 16 + half * 8;
        const f32x4 a = *(const f32x4*)pp, c = *(const f32x4*)(pp + 4); float s = ((a[0] + a[1]) + (a[2] + a[3])) + ((c[0] + c[1]) + (c[2] + c[3]));
        s += __shfl_xor(s, 1);
        if (half == 0) xs[i * 256 + rowl] = __builtin_amdgcn_rsqf(s * (1.0f / DM) + EPSN);
        if (t < 256) xs[3072 + i * 256 + t] = shw[(size_t)((u.pm * BM) >> 12) * (2 * DFF) + u.pn * BM + t]; }
    __syncthreads();
}
constexpr int NW = 8, QBLK = 32, KVBLK = 64;
constexpr float SCALE = 0.088388347648318440f, THR = 8.f;
constexpr int LDQ = DM, LDK = HD, LDO = DM;
constexpr size_t SHM_V = KVBLK * HD * 2, SHM_K = KVBLK * HD * 2, SHM_ATTN = 2 * SHM_V + 2 * SHM_K + NW * 64 * 4;
#define KSWZ(row, colB) ((row) * 256 + ((colB) ^ (((row) & 7) << 4)))
#define SBAR() __builtin_amdgcn_sched_barrier(0)
__device__ __forceinline__ int crow(int r, int hi) { return (r & 3) + 8 * (r >> 2) + 4 * hi; }
__device__ __forceinline__ void partialSM(f32x16& p0, f32x16& p1, float mnC) {
  constexpr float C = SCALE * 1.4426950408889634f;
  for (int r = 0; r < 16; ++r) p0[r] = fmaf(p0[r], C, mnC); for (int r = 0; r < 16; ++r) p1[r] = fmaf(p1[r], C, mnC);
  for (int r = 0; r < 16; ++r) p0[r] = __builtin_amdgcn_exp2f(p0[r]);
}
__device__ __forceinline__ void finishSM(f32x16& p0, f32x16& p1, float& l_reg, bf16x8& pa0, bf16x8& pa1, bf16x8& pa2, bf16x8& pa3) {
  for (int r = 0; r < 16; ++r) p1[r] = __builtin_amdgcn_exp2f(p1[r]);
  float ps = 0; for (int r = 0; r < 16; ++r) ps += p0[r]; for (int r = 0; r < 16; ++r) ps += p1[r];
  { auto rr = __builtin_amdgcn_permlane32_swap(__float_as_uint(ps), __float_as_uint(ps), false, false);
    ps = __uint_as_float(rr[0]) + __uint_as_float(rr[1]); }
  l_reg += ps;
#define PK4(P, BASE, OUT) do { unsigned a0 = cvtpk(P[BASE + 0], P[BASE + 1]), a1 = cvtpk(P[BASE + 2], P[BASE + 3]);   \
    unsigned b0 = cvtpk(P[BASE + 4], P[BASE + 5]), b1 = cvtpk(P[BASE + 6], P[BASE + 7]);                              \
    auto r0 = __builtin_amdgcn_permlane32_swap(a0, b0, false, false); auto r1 = __builtin_amdgcn_permlane32_swap(a1, b1, false, false); \
    u32x4 w = {r0[0], r1[0], r0[1], r1[1]}; OUT = *reinterpret_cast<bf16x8*>(&w); } while (0)
  PK4(p0, 0, pa0); PK4(p0, 8, pa1); PK4(p1, 0, pa2); PK4(p1, 8, pa3);
#undef PK4
}
__device__ __forceinline__ void qkt(f32x16& p0, f32x16& p1, const bf16_t* Ks, const bf16x8* qr, int r32, int hi) {
  p0 = f32x16{}; p1 = f32x16{};
  for (int d0 = 0; d0 < 8; ++d0) { int cb = (d0 * 16 + hi * 8) * 2;
    bf16x8 b0 = *reinterpret_cast<const bf16x8*>((const char*)Ks + KSWZ(r32, cb));
    bf16x8 b1 = *reinterpret_cast<const bf16x8*>((const char*)Ks + KSWZ(32 + r32, cb));
    p0 = __builtin_amdgcn_mfma_f32_32x32x16_bf16(b0, qr[d0], p0, 0, 0, 0);
    p1 = __builtin_amdgcn_mfma_f32_32x32x16_bf16(b1, qr[d0], p1, 0, 0, 0); }
}
__device__ __forceinline__ int v_st(int k, int c) { const int kk = (k & ~0xC) | ((k & 4) << 1) | ((k & 8) >> 1); return ((kk >> 3) * 4 + (c >> 5)) * 512 + ((kk & 7) * 32 + (c & 31)) * 2; }
__device__ __forceinline__ int v_rd_base(int lane) { return ((lane & 3) << 3) | (((lane >> 2) & 3) << 6) | (((lane >> 4) & 1) << 5) | (((lane >> 5) & 1) << 8); }
constexpr int v_rd_off(int d0, int ks, int half) { return d0 * 512 + ks * 4096 + half * 2048; }
template <int OFF> __device__ __forceinline__ s16x4 tr_read(int vb) {
  s16x4 r; asm volatile("ds_read_b64_tr_b16 %0, %1 offset:%2" : "=&v"(r) : "v"(vb), "i"(OFF) : "memory"); return r;
}
template <int D0> __device__ __forceinline__ void pv_one(f32x16& od, int vb, bf16x8 pa0, bf16x8 pa1, bf16x8 pa2, bf16x8 pa3) {
  const s16x4 l0 = tr_read<v_rd_off(D0, 0, 0)>(vb), h0 = tr_read<v_rd_off(D0, 0, 1)>(vb), l1 = tr_read<v_rd_off(D0, 1, 0)>(vb), h1 = tr_read<v_rd_off(D0, 1, 1)>(vb);
  const s16x4 l2 = tr_read<v_rd_off(D0, 2, 0)>(vb), h2 = tr_read<v_rd_off(D0, 2, 1)>(vb), l3 = tr_read<v_rd_off(D0, 3, 0)>(vb), h3 = tr_read<v_rd_off(D0, 3, 1)>(vb);
  asm volatile("s_waitcnt lgkmcnt(0)" ::: "memory"); SBAR();
#define PK(L, H) (bf16x8){L[0], L[1], L[2], L[3], H[0], H[1], H[2], H[3]}
  od = __builtin_amdgcn_mfma_f32_32x32x16_bf16(pa0, PK(l0, h0), od, 0, 0, 0);
  od = __builtin_amdgcn_mfma_f32_32x32x16_bf16(pa1, PK(l1, h1), od, 0, 0, 0);
  od = __builtin_amdgcn_mfma_f32_32x32x16_bf16(pa2, PK(l2, h2), od, 0, 0, 0);
  od = __builtin_amdgcn_mfma_f32_32x32x16_bf16(pa3, PK(l3, h3), od, 0, 0, 0);
#undef PK
}
__device__ __forceinline__ void pv_d0(f32x16* o, int vb, bf16x8 pa0, bf16x8 pa1, bf16x8 pa2, bf16x8 pa3) {
  pv_one<0>(o[0], vb, pa0, pa1, pa2, pa3); pv_one<1>(o[1], vb, pa0, pa1, pa2, pa3); pv_one<2>(o[2], vb, pa0, pa1, pa2, pa3); pv_one<3>(o[3], vb, pa0, pa1, pa2, pa3);
}
__device__ __forceinline__ void attn_dense_body(const bf16_t* __restrict__ Qb, const bf16_t* __restrict__ Kh, const bf16_t* __restrict__ Vh,
                                                bf16_t* __restrict__ Ob, int seq, char* lds, LAS unsigned char* ldsl, float mnC) {
  const int tid = threadIdx.x, wid = __builtin_amdgcn_readfirstlane(tid >> 6), lane = tid & 63, r32 = lane & 31, hi = lane >> 5;
  constexpr int SLOT = 32768;
  float* ws = (float*)(lds + 3 * SLOT) + wid * 64; float* li_l = ws;
  float l_reg = 0; f32x16 o[4] = {}; bf16x8 qr[8];
  unsigned voffK[2], voffV[2];
#pragma unroll
  for (int i = 0; i < 2; ++i) { const int P16 = i * 512 + tid;
    { const int row = P16 >> 4, g = (P16 & 15) ^ (row & 7); voffK[i] = (unsigned)(row * LDK + g * 8) * 2u; }
    { const int sub = P16 >> 5, kk = (sub >> 2) * 8 + ((P16 >> 2) & 7), c = (sub & 3) * 32 + (P16 & 3) * 8, k = (kk & ~0xC) | ((kk & 4) << 1) | ((kk & 8) >> 1);
      voffV[i] = (unsigned)(k * LDK + c) * 2u; } }
#define ADMA(jt, b) do { const char* _gk = (const char*)Kh + (size_t)(jt) * (KVBLK * LDK * 2); const char* _gv = (const char*)Vh + (size_t)(jt) * (KVBLK * LDK * 2); \
    _Pragma("unroll") for (int _i = 0; _i < 2; ++_i) { \
      __builtin_amdgcn_global_load_lds((const unsigned*)(_gv + voffV[_i]), (LAS unsigned*)(ldsl + (b) * SLOT + wid * 1024 + _i * 8192), 16, 0, 0); \
      __builtin_amdgcn_global_load_lds((const unsigned*)(_gk + voffK[_i]), (LAS unsigned*)(ldsl + (b) * SLOT + 16384 + wid * 1024 + _i * 8192), 16, 0, 0); } } while (0)
#define KBUF(b) ((const bf16_t*)(lds + (b) * SLOT + 16384))
  const int NT = seq / KVBLK;
  ADMA(0, 0); ADMA(1, 1);
  const bf16_t* Qw = Qb + (long)(wid * QBLK + r32) * LDQ + hi * 8;
#pragma unroll
  for (int d0 = 0; d0 < 8; ++d0) qr[d0] = *reinterpret_cast<const bf16x8*>(Qw + d0 * 16);
  const int vb0 = (int)(uintptr_t)lds + v_rd_base(lane);
  f32x16 pA0, pA1, pB0, pB1; bf16x8 pa0, pa1, pa2, pa3;
  asm volatile("s_waitcnt vmcnt(0)" ::: "memory"); __syncthreads();
  qkt(pA0, pA1, KBUF(0), qr, r32, hi); partialSM(pA0, pA1, mnC);
  int bv = 0, bk = 1, bn = 2;
  for (int j = 1; j + 1 < NT; j += 2) {
    ADMA(j + 1, bn);
    SBAR(); qkt(pB0, pB1, KBUF(bk), qr, r32, hi);
    finishSM(pA0, pA1, l_reg, pa0, pa1, pa2, pa3); SBAR();
    pv_d0(o, vb0 + bv * SLOT, pa0, pa1, pa2, pa3); partialSM(pB0, pB1, mnC);
    asm volatile("s_waitcnt vmcnt(0)" ::: "memory"); __syncthreads();
    { const int t_ = bv; bv = bk; bk = bn; bn = t_; }
    if (j + 2 < NT) ADMA(j + 2, bn);
    SBAR(); qkt(pA0, pA1, KBUF(bk), qr, r32, hi);
    finishSM(pB0, pB1, l_reg, pa0, pa1, pa2, pa3); SBAR();
    pv_d0(o, vb0 + bv * SLOT, pa0, pa1, pa2, pa3); partialSM(pA0, pA1, mnC);
    asm volatile("s_waitcnt vmcnt(0)" ::: "memory"); __syncthreads();
    { const int t_ = bv; bv = bk; bk = bn; bn = t_; }
  }
  SBAR(); qkt(pB0, pB1, KBUF(bk), qr, r32, hi);
  finishSM(pA0, pA1, l_reg, pa0, pa1, pa2, pa3); SBAR();
  pv_d0(o, vb0 + bv * SLOT, pa0, pa1, pa2, pa3); partialSM(pB0, pB1, mnC);
  finishSM(pB0, pB1, l_reg, pa0, pa1, pa2, pa3); SBAR();
  pv_d0(o, vb0 + bk * SLOT, pa0, pa1, pa2, pa3);
  if (hi == 0) li_l[r32] = l_reg; asm volatile("s_waitcnt lgkmcnt(0)" ::: "memory");
  float rli[16];
#pragma unroll
  for (int r = 0; r < 16; ++r) rli[r] = __builtin_amdgcn_rcpf(li_l[crow(r, hi)]);
  bf16_t* Ow = Ob + (long)(wid * QBLK) * LDO;
#pragma unroll
  for (int r = 0; r < 16; ++r) { int orow = crow(r, hi);
    for (int d0 = 0; d0 < 4; ++d0) Ow[(long)orow * LDO + d0 * 32 + r32] = (bf16_t)(cvtpk(o[d0][r] * rli[r], 0.f) & 0xffffu); }
#undef ADMA
#undef KBUF
}

__device__ __forceinline__ void phase_fft1(const bf16_t* __restrict__ Xb, const float* __restrict__ ssq, const float* __restrict__ gmix, const float* __restrict__ modl,
                                           bf16_t* __restrict__ AP, char* lds) {
    const int tid = threadIdx.x, wid = tid >> 6, lane = tid & 63, r32 = lane & 31, hi = lane >> 5, kb = wid & 3, dh = wid >> 2, G = gridDim.x;
    float* tab = (float*)(lds + 65536);
    float* rs = (float*)(lds + 81920);
    for (int i = tid; i < 4096; i += 512) tab[i] = __builtin_amdgcn_cosf((float)i * (1.0f / 4096.0f));
    for (int idx = tid; idx < 1024; idx += 512) { const int i = idx >> 6, n1 = idx & 63, t = blockIdx.x + G * i;
        if (t < 4096) { const float* pp = ssq + (size_t)((t >> 9) * SEQ + 64 * n1 + ((t >> 3) & 63)) * 16;
            const f32x4 a = *(const f32x4*)pp, b = *(const f32x4*)(pp + 4), c = *(const f32x4*)(pp + 8), d = *(const f32x4*)(pp + 12);
            const float s = (((a[0] + a[1]) + (a[2] + a[3])) + ((b[0] + b[1]) + (b[2] + b[3]))) + (((c[0] + c[1]) + (c[2] + c[3])) + ((d[0] + d[1]) + (d[2] + d[3])));
            rs[idx] = __builtin_amdgcn_rsqf(s * (1.0f / DM) + EPSN); } }
    __syncthreads();
    bf16x8 pa[4];
    { const int k1 = 16 * kb + (r32 & 15), isim = r32 >> 4;
#pragma unroll
      for (int j = 0; j < 4; ++j) { u32x4 w; unsigned ww[4];
#pragma unroll
        for (int e2 = 0; e2 < 4; ++e2) { float v[2];
#pragma unroll
          for (int q = 0; q < 2; ++q) { const int n1 = 16 * j + 8 * hi + 2 * e2 + q, m = ((k1 * n1) & 63) * 64; v[q] = tab[isim ? ((m + 1024) & 4095) : m] * 0.125f; }
          ww[e2] = cvtpk(v[0], v[1]); }
        w.x = ww[0]; w.y = ww[1]; w.z = ww[2]; w.w = ww[3]; pa[j] = *reinterpret_cast<bf16x8*>(&w); } }
    const int sr = tid >> 4, sc = (tid & 15) * 8, vst0 = v_st(sr, sc), vst1 = v_st(32 + sr, sc);
    const int vb0 = (int)(uintptr_t)lds + v_rd_base(lane) + dh * 1024;
    u32x4 s0, s1; f32x4 pg0, pg1, psh0, psh1, psc0, psc1;
#define F1_SRC(t, n1) (Xb + ((size_t)(((t) >> 9) * SEQ + 64 * (n1) + (((t) >> 3) & 63))) * DM + ((t) & 7) * 128 + sc)
#define F1_LOAD(t) do { s0 = *reinterpret_cast<const u32x4*>(F1_SRC(t, sr)); s1 = *reinterpret_cast<const u32x4*>(F1_SRC(t, 32 + sr)); \
        const int ch0 = ((t) & 7) * 128 + sc; const float* mp = modl + (size_t)((t) >> 9) * 6144 + ch0; \
        pg0 = *(const f32x4*)(gmix + ch0); pg1 = *(const f32x4*)(gmix + ch0 + 4); psh0 = *(const f32x4*)mp; psh1 = *(const f32x4*)(mp + 4); \
        psc0 = *(const f32x4*)(mp + 1024) + 1.0f; psc1 = *(const f32x4*)(mp + 1028) + 1.0f; } while (0)
#define F1_NORM(S, R) ({ const f32x4 x0 = (f32x4){__uint_as_float(S[0] << 16), __uint_as_float(S[0] & 0xffff0000u), __uint_as_float(S[1] << 16), __uint_as_float(S[1] & 0xffff0000u)}; \
        const f32x4 x1 = (f32x4){__uint_as_float(S[2] << 16), __uint_as_float(S[2] & 0xffff0000u), __uint_as_float(S[3] << 16), __uint_as_float(S[3] & 0xffff0000u)}; \
        const f32x4 y0 = (x0 * (R) * pg0) * psc0 + psh0, y1 = (x1 * (R) * pg1) * psc1 + psh1; \
        u32x4 w; w.x = cvtpk(y0[0], y0[1]); w.y = cvtpk(y0[2], y0[3]); w.z = cvtpk(y1[0], y1[1]); w.w = cvtpk(y1[2], y1[3]); w; })
    int t = blockIdx.x, buf = 0, it = 0;
    if (t < 4096) F1_LOAD(t);
    for (; t < 4096; t += G, ++it) {
        { const float r0 = rs[it * 64 + sr], r1 = rs[it * 64 + 32 + sr];
          const u32x4 w0 = F1_NORM(s0, r0), w1 = F1_NORM(s1, r1);
          *(u32x4*)(lds + buf * 16384 + vst0) = w0; *(u32x4*)(lds + buf * 16384 + vst1) = w1; }
        __syncthreads();
        const int tn = t + G;
        if (tn < 4096) F1_LOAD(tn);
        if (kb < 3) {
        f32x16 o0 = {}, o1 = {};
        const int vb = vb0 + buf * 16384;
        pv_one<0>(o0, vb, pa[0], pa[1], pa[2], pa[3]); pv_one<1>(o1, vb, pa[0], pa[1], pa[2], pa[3]);
        const int b = t >> 9, n2 = (t >> 3) & 63, chblk = t & 7;
#pragma unroll
        for (int r = 0; r < 8; ++r) { const int k1 = 16 * kb + crow(r, hi), m = (k1 * n2) & 4095; const float cw = tab[m], sw = tab[(m + 1024) & 4095];
            bf16_t* dst = AP + ((((size_t)b * 64 + k1) * 2) * 64 + n2) * DM + chblk * 128 + dh * 64 + r32;
            const float re0 = o0[r], im0 = o0[r + 8], re1 = o1[r], im1 = o1[r + 8];
            if (k1 <= 32) {
            dst[0] = (bf16_t)(cvtpk(re0 * cw - im0 * sw, 0.f) & 0xffffu); dst[32] = (bf16_t)(cvtpk(re1 * cw - im1 * sw, 0.f) & 0xffffu);
            dst[65536] = (bf16_t)(cvtpk(re0 * sw + im0 * cw, 0.f) & 0xffffu); dst[65536 + 32] = (bf16_t)(cvtpk(re1 * sw + im1 * cw, 0.f) & 0xffffu); } }
        }
        buf ^= 1;
    }
#undef F1_SRC
#undef F1_LOAD
#undef F1_NORM
    __syncthreads();
}
__device__ __forceinline__ void phase_fft3(const bf16_t* __restrict__ AP, bf16_t* __restrict__ Z, char* lds) {
    const int tid = threadIdx.x, wid = tid >> 6, lane = tid & 63, r32 = lane & 31, hi = lane >> 5, kb = wid & 3, dh = wid >> 2, G = gridDim.x;
    float* tab = (float*)(lds + 65536);
    for (int i = tid; i < 4096; i += 512) tab[i] = __builtin_amdgcn_cosf((float)i * (1.0f / 4096.0f));
    __syncthreads();
    bf16x8 pa[8];
    { const int k2 = 16 * kb + (r32 & 15), ri = r32 >> 4;
#pragma unroll
      for (int j = 0; j < 8; ++j) { u32x4 w; unsigned ww[4];
#pragma unroll
        for (int e2 = 0; e2 < 4; ++e2) { float v[2];
#pragma unroll
          for (int q = 0; q < 2; ++q) { const int kap = 16 * j + 8 * hi + 2 * e2 + q, rip = kap >> 6, n2 = kap & 63, m = ((k2 * n2) & 63) * 64;
              const int id = (ri == rip) ? m : (ri == 0 ? ((m - 1024) & 4095) : ((m + 1024) & 4095));
              v[q] = tab[id] * 0.125f; }
          ww[e2] = cvtpk(v[0], v[1]); }
        w.x = ww[0]; w.y = ww[1]; w.z = ww[2]; w.w = ww[3]; pa[j] = *reinterpret_cast<bf16x8*>(&w); } }
    const int sr = tid >> 4, sc = (tid & 15) * 8, vst0 = v_st(sr, sc), vst1 = v_st(32 + sr, sc);
    const int vb0 = (int)(uintptr_t)lds + v_rd_base(lane) + dh * 1024;
    bf16x8 s0, s1, s2, s3;
    constexpr int NT3 = NBATCH * 33 * 8;
#define T3_IDX(tp) ((((tp) >> 3) / 33) * 64 + (((tp) >> 3) % 33))
#define F3_SRC(tp, rip, n2) (AP + (((size_t)T3_IDX(tp) * 2 + (rip)) * 64 + (n2)) * DM + ((tp) & 7) * 128 + sc)
    int t = blockIdx.x, buf = 0;
    if (t < NT3) { s0 = *reinterpret_cast<const bf16x8*>(F3_SRC(t, 0, sr)); s1 = *reinterpret_cast<const bf16x8*>(F3_SRC(t, 0, 32 + sr));
                   s2 = *reinterpret_cast<const bf16x8*>(F3_SRC(t, 1, sr)); s3 = *reinterpret_cast<const bf16x8*>(F3_SRC(t, 1, 32 + sr)); }
    for (; t < NT3; t += G) {
        char* lb = lds + buf * 32768;
        *(bf16x8*)(lb + vst0) = s0; *(bf16x8*)(lb + vst1) = s1; *(bf16x8*)(lb + 16384 + vst0) = s2; *(bf16x8*)(lb + 16384 + vst1) = s3;
        __syncthreads();
        const int tn = t + G;
        if (tn < NT3) { s0 = *reinterpret_cast<const bf16x8*>(F3_SRC(tn, 0, sr)); s1 = *reinterpret_cast<const bf16x8*>(F3_SRC(tn, 0, 32 + sr));
                        s2 = *reinterpret_cast<const bf16x8*>(F3_SRC(tn, 1, sr)); s3 = *reinterpret_cast<const bf16x8*>(F3_SRC(tn, 1, 32 + sr)); }
        f32x16 o0 = {}, o1 = {};
        const int vb = vb0 + buf * 32768;
        pv_one<0>(o0, vb, pa[0], pa[1], pa[2], pa[3]); pv_one<1>(o1, vb, pa[0], pa[1], pa[2], pa[3]);
        pv_one<0>(o0, vb + 16384, pa[4], pa[5], pa[6], pa[7]); pv_one<1>(o1, vb + 16384, pa[4], pa[5], pa[6], pa[7]);
        const int idx = T3_IDX(t), b = idx >> 6, k1 = idx & 63, ch = (t & 7) * 128 + dh * 64 + r32, g = ch >> 8, cw = ch & 255;
        const bool mir = (k1 >= 1) && (k1 <= 31);
#pragma unroll
        for (int r = 0; r < 8; ++r) { const int k2 = 16 * kb + crow(r, hi);
            const unsigned re0 = cvtpk(o0[r], 0.f) & 0xffffu, re1 = cvtpk(o1[r], 0.f) & 0xffffu;
            bf16_t* dst = Z + ((size_t)(b * SEQ + k1 + 64 * k2)) * 2048 + g * 512 + cw;
            dst[0] = (bf16_t)re0; dst[32] = (bf16_t)re1;
            dst[256] = (bf16_t)(cvtpk(o0[r + 8], 0.f) & 0xffffu); dst[256 + 32] = (bf16_t)(cvtpk(o1[r + 8], 0.f) & 0xffffu);
            if (mir) { bf16_t* dm = Z + ((size_t)(b * SEQ + (64 - k1) + 64 * (63 - k2))) * 2048 + g * 512 + cw;
                dm[0] = (bf16_t)re0; dm[32] = (bf16_t)re1;
                dm[256] = (bf16_t)(cvtpk(-o0[r + 8], 0.f) & 0xffffu); dm[256 + 32] = (bf16_t)(cvtpk(-o1[r + 8], 0.f) & 0xffffu); } }
        buf ^= 1;
    }
#undef T3_IDX
#undef F3_SRC
    __syncthreads();
}

__device__ __forceinline__ float wave_sum(float s) {
    s += __shfl_xor(s, 1); s += __shfl_xor(s, 2); s += __shfl_xor(s, 4); s += __shfl_xor(s, 8); s += __shfl_xor(s, 16); s += __shfl_xor(s, 32); return s;
}
__device__ __forceinline__ void normmod_rows(const float* __restrict__ src, bf16_t* __restrict__ dst, const float* __restrict__ g, const float* __restrict__ modl,
                                             int jshift, int nrows, int bshift, int brow0) {
    const int lane = threadIdx.x & 63, gw = blockIdx.x * 8 + (threadIdx.x >> 6), nw = gridDim.x * 8;
    f32x4 gv[4];
#pragma unroll
    for (int i = 0; i < 4; ++i) gv[i] = *(const f32x4*)(g + lane * 4 + 256 * i);
    for (int row = gw; row < nrows; row += 2 * nw) {
        const int row2 = row + nw; const bool has2 = row2 < nrows;
        const float* x0 = src + (size_t)row * DM + lane * 4; const float* x1 = src + (size_t)(has2 ? row2 : row) * DM + lane * 4;
        f32x4 v0[4], v1[4];
#pragma unroll
        for (int i = 0; i < 4; ++i) { v0[i] = *(const f32x4*)(x0 + 256 * i); v1[i] = *(const f32x4*)(x1 + 256 * i); }
        float s0 = 0.f, s1 = 0.f;
#pragma unroll
        for (int i = 0; i < 4; ++i) { s0 += (v0[i][0] * v0[i][0] + v0[i][1] * v0[i][1]) + (v0[i][2] * v0[i][2] + v0[i][3] * v0[i][3]);
                                      s1 += (v1[i][0] * v1[i][0] + v1[i][1] * v1[i][1]) + (v1[i][2] * v1[i][2] + v1[i][3] * v1[i][3]); }
        s0 = wave_sum(s0); s1 = wave_sum(s1);
        const float r0 = __builtin_amdgcn_rsqf(s0 * (1.0f / DM) + EPSN), r1 = __builtin_amdgcn_rsqf(s1 * (1.0f / DM) + EPSN);
        const float* m0 = modl + (size_t)(brow0 + (row >> bshift)) * 6144 + jshift * 1024 + lane * 4;
        const float* m1 = modl + (size_t)(brow0 + ((has2 ? row2 : row) >> bshift)) * 6144 + jshift * 1024 + lane * 4;
#pragma unroll
        for (int i = 0; i < 4; ++i) {
            const f32x4 sh0 = *(const f32x4*)(m0 + 256 * i), sc0 = *(const f32x4*)(m0 + 1024 + 256 * i);
            const f32x4 y0 = (v0[i] * r0 * gv[i]) * (sc0 + 1.0f) + sh0;
            u32x2 w0; w0.x = cvtpk(y0[0], y0[1]); w0.y = cvtpk(y0[2], y0[3]);
            *(u32x2*)(dst + (size_t)row * DM + lane * 4 + 256 * i) = w0;
            if (has2) { const f32x4 sh1 = *(const f32x4*)(m1 + 256 * i), sc1 = *(const f32x4*)(m1 + 1024 + 256 * i);
                const f32x4 y1 = (v1[i] * r1 * gv[i]) * (sc1 + 1.0f) + sh1;
                u32x2 w1; w1.x = cvtpk(y1[0], y1[1]); w1.y = cvtpk(y1[2], y1[3]);
                *(u32x2*)(dst + (size_t)row2 * DM + lane * 4 + 256 * i) = w1; }
        }
    }
}
__device__ __forceinline__ void final_norm(const float* __restrict__ src, float* __restrict__ dst, const float* __restrict__ g) {
    const int lane = threadIdx.x & 63, gw = blockIdx.x * 8 + (threadIdx.x >> 6), nw = gridDim.x * 8;
    f32x4 gv[4];
#pragma unroll
    for (int i = 0; i < 4; ++i) gv[i] = *(const f32x4*)(g + lane * 4 + 256 * i);
    for (int row = gw; row < MTOK; row += 2 * nw) {
        const int row2 = row + nw; const bool has2 = row2 < MTOK;
        const float* x0 = src + (size_t)row * DM + lane * 4; const float* x1 = src + (size_t)(has2 ? row2 : row) * DM + lane * 4;
        f32x4 v0[4], v1[4];
#pragma unroll
        for (int i = 0; i < 4; ++i) { v0[i] = *(const f32x4*)(x0 + 256 * i); v1[i] = *(const f32x4*)(x1 + 256 * i); }
        float s0 = 0.f, s1 = 0.f;
#pragma unroll
        for (int i = 0; i < 4; ++i) { s0 += (v0[i][0] * v0[i][0] + v0[i][1] * v0[i][1]) + (v0[i][2] * v0[i][2] + v0[i][3] * v0[i][3]);
                                      s1 += (v1[i][0] * v1[i][0] + v1[i][1] * v1[i][1]) + (v1[i][2] * v1[i][2] + v1[i][3] * v1[i][3]); }
        s0 = wave_sum(s0); s1 = wave_sum(s1);
        const float r0 = __builtin_amdgcn_rsqf(s0 * (1.0f / DM) + EPSN), r1 = __builtin_amdgcn_rsqf(s1 * (1.0f / DM) + EPSN);
#pragma unroll
        for (int i = 0; i < 4; ++i) { *(f32x4*)(dst + (size_t)row * DM + lane * 4 + 256 * i) = v0[i] * r0 * gv[i];
            if (has2) *(f32x4*)(dst + (size_t)row2 * DM + lane * 4 + 256 * i) = v1[i] * r1 * gv[i]; }
    }
}

__device__ __forceinline__ void normmod_rows_b(const bf16_t* __restrict__ src, bf16_t* __restrict__ dst, const float* __restrict__ g, const float* __restrict__ modl, int jshift, int nrows) {
    const int lane = threadIdx.x & 63, gw = blockIdx.x * 8 + (threadIdx.x >> 6), nw = gridDim.x * 8;
    f32x4 gv[4];
    gv[0] = *(const f32x4*)(g + lane * 8); gv[1] = *(const f32x4*)(g + lane * 8 + 4); gv[2] = *(const f32x4*)(g + 512 + lane * 8); gv[3] = *(const f32x4*)(g + 512 + lane * 8 + 4);
    for (int row = gw; row < nrows; row += nw) {
        const u32x4 a0 = *(const u32x4*)(src + (size_t)row * DM + lane * 8), a1 = *(const u32x4*)(src + (size_t)row * DM + 512 + lane * 8);
        f32x4 v[4];
        v[0] = (f32x4){__uint_as_float(a0[0] << 16), __uint_as_float(a0[0] & 0xffff0000u), __uint_as_float(a0[1] << 16), __uint_as_float(a0[1] & 0xffff0000u)};
        v[1] = (f32x4){__uint_as_float(a0[2] << 16), __uint_as_float(a0[2] & 0xffff0000u), __uint_as_float(a0[3] << 16), __uint_as_float(a0[3] & 0xffff0000u)};
        v[2] = (f32x4){__uint_as_float(a1[0] << 16), __uint_as_float(a1[0] & 0xffff0000u), __uint_as_float(a1[1] << 16), __uint_as_float(a1[1] & 0xffff0000u)};
        v[3] = (f32x4){__uint_as_float(a1[2] << 16), __uint_as_float(a1[2] & 0xffff0000u), __uint_as_float(a1[3] << 16), __uint_as_float(a1[3] & 0xffff0000u)};
        float s = 0.f;
#pragma unroll
        for (int i = 0; i < 4; ++i) s += (v[i][0] * v[i][0] + v[i][1] * v[i][1]) + (v[i][2] * v[i][2] + v[i][3] * v[i][3]);
        s = wave_sum(s);
        const float r = __builtin_amdgcn_rsqf(s * (1.0f / DM) + EPSN);
        const float* m0 = modl + (size_t)(row >> 12) * 6144 + jshift * 1024;
        u32x4 w[2];
#pragma unroll
        for (int i = 0; i < 4; ++i) { const int c = (i >> 1) * 512 + lane * 8 + (i & 1) * 4;
            const f32x4 sh = *(const f32x4*)(m0 + c), sc = *(const f32x4*)(m0 + 1024 + c);
            const f32x4 y = (v[i] * r * gv[i]) * (sc + 1.0f) + sh;
            w[i >> 1][(i & 1) * 2] = cvtpk(y[0], y[1]); w[i >> 1][(i & 1) * 2 + 1] = cvtpk(y[2], y[3]); }
        *(u32x4*)(dst + (size_t)row * DM + lane * 8) = w[0]; *(u32x4*)(dst + (size_t)row * DM + 512 + lane * 8) = w[1];
    }
}
__device__ __forceinline__ void final_norm_bf16(const bf16_t* __restrict__ xb, const float* __restrict__ ssq, float* __restrict__ dst, const float* __restrict__ g) {
    const int lane = threadIdx.x & 63, gw = blockIdx.x * 8 + (threadIdx.x >> 6), nw = gridDim.x * 8;
    f32x4 gv[4];
    gv[0] = *(const f32x4*)(g + lane * 8); gv[1] = *(const f32x4*)(g + lane * 8 + 4); gv[2] = *(const f32x4*)(g + 512 + lane * 8); gv[3] = *(const f32x4*)(g + 512 + lane * 8 + 4);
    for (int row = gw; row < MTOK; row += 2 * nw) {
        const int row2 = (row + nw < MTOK) ? row + nw : row;
        const u32x4 a0 = *(const u32x4*)(xb + (size_t)row * DM + lane * 8), a1 = *(const u32x4*)(xb + (size_t)row * DM + 512 + lane * 8);
        const u32x4 b0 = *(const u32x4*)(xb + (size_t)row2 * DM + lane * 8), b1 = *(const u32x4*)(xb + (size_t)row2 * DM + 512 + lane * 8);
        float s0 = (lane < 16) ? ssq[(size_t)row * 16 + lane] : 0.f, s1 = (lane < 16) ? ssq[(size_t)row2 * 16 + lane] : 0.f;
        s0 = wave_sum(s0); s1 = wave_sum(s1);
        const float r0 = __builtin_amdgcn_rsqf(s0 * (1.0f / DM) + EPSN), r1 = __builtin_amdgcn_rsqf(s1 * (1.0f / DM) + EPSN);
#define FN_OUT(A, R, ROW, OFF, G0, G1) do { f32x4 y0, y1; \
        y0[0] = __uint_as_float(A[0] << 16); y0[1] = __uint_as_float(A[0] & 0xffff0000u); y0[2] = __uint_as_float(A[1] << 16); y0[3] = __uint_as_float(A[1] & 0xffff0000u); \
        y1[0] = __uint_as_float(A[2] << 16); y1[1] = __uint_as_float(A[2] & 0xffff0000u); y1[2] = __uint_as_float(A[3] << 16); y1[3] = __uint_as_float(A[3] & 0xffff0000u); \
        *(f32x4*)(dst + (size_t)(ROW) * DM + (OFF)) = y0 * (R) * (G0); *(f32x4*)(dst + (size_t)(ROW) * DM + (OFF) + 4) = y1 * (R) * (G1); } while (0)
        FN_OUT(a0, r0, row, lane * 8, gv[0], gv[1]); FN_OUT(a1, r0, row, 512 + lane * 8, gv[2], gv[3]);
        if (row2 != row) { FN_OUT(b0, r1, row2, lane * 8, gv[0], gv[1]); FN_OUT(b1, r1, row2, 512 + lane * 8, gv[2], gv[3]); }
#undef FN_OUT
    }
}
__device__ __forceinline__ void shiftw_rows(const bf16_t* __restrict__ Wt, const float* __restrict__ mod, float* __restrict__ shw) {
    const int lane = threadIdx.x & 63, gw = blockIdx.x * 8 + (threadIdx.x >> 6), nw = gridDim.x * 8;
    for (int l = 0; l < 2; ++l) {
        f32x4 sh[8][4];
#pragma unroll
        for (int b = 0; b < 8; ++b) { const float* sp = mod + (size_t)(l * 9 + b) * 6144 + 3 * 1024 + lane * 8;
            sh[b][0] = *(const f32x4*)sp; sh[b][1] = *(const f32x4*)(sp + 4); sh[b][2] = *(const f32x4*)(sp + 512); sh[b][3] = *(const f32x4*)(sp + 516); }
        for (int n = gw; n < 2 * DFF; n += nw) {
            const bf16_t* wp = Wt + ((size_t)l * 2 * DFF + n) * DM + lane * 8;
            const u32x4 w0 = *(const u32x4*)wp, w1 = *(const u32x4*)(wp + 512);
            float wf[16];
#pragma unroll
            for (int q = 0; q < 4; ++q) { wf[2 * q] = __uint_as_float(w0[q] << 16); wf[2 * q + 1] = __uint_as_float(w0[q] & 0xffff0000u);
                                          wf[8 + 2 * q] = __uint_as_float(w1[q] << 16); wf[8 + 2 * q + 1] = __uint_as_float(w1[q] & 0xffff0000u); }
            float r[8];
#pragma unroll
            for (int b = 0; b < 8; ++b) { float s = 0.f;
#pragma unroll
                for (int q = 0; q < 4; ++q) s += (sh[b][q][0] * wf[4 * q] + sh[b][q][1] * wf[4 * q + 1]) + (sh[b][q][2] * wf[4 * q + 2] + sh[b][q][3] * wf[4 * q + 3]);
                r[b] = wave_sum(s); }
            if (lane < 8) { float v = r[0];
#pragma unroll
                for (int b = 1; b < 8; ++b) v = (lane == b) ? r[b] : v;
                shw[((size_t)l * 8 + lane) * (2 * DFF) + n] = v; }
        }
    }
}

constexpr int N_GEMV = 96, N_TR = 5120 / 4, N_FPOS = 0, N_CS = 4, N_ROPE = 1;
constexpr int IT_TR = N_GEMV, IT_FPOS = IT_TR + N_TR, IT_CS = IT_FPOS + N_FPOS, IT_ROPE = IT_CS + N_CS, N_ITEMS = IT_ROPE + N_ROPE;
__device__ __forceinline__ void phase_prep(const Params& p, LAS unsigned char* lds) {
    const int tid = threadIdx.x;
    unsigned char* ws = p.ws;
    LAS float* tab = (LAS float*)(lds + 114688);
    for (int i = tid; i < 4096; i += 512) tab[i] = __builtin_amdgcn_cosf((float)i * (1.0f / 4096.0f)) * (1.0f / 64.0f);
    __syncthreads();
    for (int it = blockIdx.x; it < N_ITEMS; it += gridDim.x) {
        if (it < IT_TR) {
            const int layer = it / 48, col0 = (it % 48) * 128;
            LAS float* sv = (LAS float*)lds; LAS float* red = (LAS float*)(lds + 36864);
            for (int i = tid; i < 9216; i += 512) { const int r = i >> 10, k = i & 1023; const float x = (r < 8) ? p.c[r * 1024 + k] : p.c_ctx[k]; sv[i] = x / (1.0f + __expf(-x)); }
            __syncthreads();
            const int kk = tid >> 5, c4 = tid & 31;
            const float* W = p.w_mod + (size_t)layer * 1024 * 6144 + col0 + c4 * 4;
            f32x4 acc[9];
#pragma unroll
            for (int r = 0; r < 9; ++r) acc[r] = (f32x4){0.f, 0.f, 0.f, 0.f};
#pragma unroll 4
            for (int i = 0; i < 64; ++i) { const int k = kk + 16 * i; const f32x4 w = *(const f32x4*)(W + (size_t)k * 6144);
#pragma unroll
                for (int r = 0; r < 9; ++r) acc[r] += w * sv[r * 1024 + k]; }
#pragma unroll
            for (int r = 0; r < 9; ++r) *(LAS f32x4*)(red + (kk * 9 + r) * 128 + c4 * 4) = acc[r];
            __syncthreads();
            float* mod = (float*)(ws + WS_MOD);
            for (int o = tid; o < 1152; o += 512) { const int r = o >> 7, ci = o & 127; float s = p.b_mod[layer * 6144 + col0 + ci];
                for (int q = 0; q < 16; ++q) s += red[(q * 9 + r) * 128 + ci];
                mod[(size_t)(layer * 9 + r) * 6144 + col0 + ci] = s; }
            __syncthreads();
        } else if (it < IT_FPOS) {
            LAS float* tile = (LAS float*)lds;
            const float* src; bf16_t* dst; int K, N, mode, t0;
#define TR_JOB(tt) do { int t = (tt); mode = 0; \
            if (t < 384) { src = p.w_qkv; dst = (bf16_t*)(ws + WS_WQKV); K = 1024; N = NQKV; mode = 1; } \
            else if (t < 640) { t -= 384; src = p.w_o; dst = (bf16_t*)(ws + WS_WO); K = 1024; N = 1024; } \
            else if (t < 896) { t -= 640; src = p.w_f; dst = (bf16_t*)(ws + WS_WF); K = 1024; N = 1024; } \
            else if (t < 2304) { t -= 896; src = p.w_gu; dst = (bf16_t*)(ws + WS_WGU); K = 1024; N = 2 * DFF; mode = 2; } \
            else if (t < 3712) { t -= 2304; src = p.w_gu + (size_t)1024 * 2 * DFF; dst = (bf16_t*)(ws + WS_WGU) + (size_t)2 * DFF * 1024; K = 1024; N = 2 * DFF; mode = 2; } \
            else if (t < 4416) { t -= 3712; src = p.w_d; dst = (bf16_t*)(ws + WS_WD); K = DFF; N = 1024; } \
            else { t -= 4416; src = p.w_d + (size_t)DFF * 1024; dst = (bf16_t*)(ws + WS_WD) + (size_t)1024 * DFF; K = DFF; N = 1024; } t0 = t; } while (0)
            TR_JOB((it - IT_TR) * 4);
            const int nkt = K / 64;
#pragma unroll
            for (int q = 0; q < 4; ++q) { const int t = t0 + q, kb = (t % nkt) * 64, n0 = (t / nkt) * 64;
                const int col = tid & 63, k0 = tid >> 6, np = n0 + col; int sc = np;
                if (mode == 1 && np < 1280) { const int i = np & 127; sc = (np & ~127) + (i >> 1) + 64 * (i & 1); }
                if (mode == 2) { const int r = np & 255, pn = np >> 8; sc = (r >> 7) * DFF + pn * 128 + (r & 127); }
#pragma unroll
                for (int i = 0; i < 8; ++i) { const int k = k0 + 8 * i; tile[q * 4160 + k * 65 + col] = src[(size_t)(kb + k) * N + sc]; } }
            __syncthreads();
#pragma unroll
            for (int q = 0; q < 4; ++q) { const int t = t0 + q, kb = (t % nkt) * 64, n0 = (t / nkt) * 64;
                const int nl = tid >> 3, ks = (tid & 7) * 8; float v[8];
#pragma unroll
                for (int j = 0; j < 8; ++j) v[j] = tile[q * 4160 + (ks + j) * 65 + nl];
                u32x4 w; w.x = cvtpk(v[0], v[1]); w.y = cvtpk(v[2], v[3]); w.z = cvtpk(v[4], v[5]); w.w = cvtpk(v[6], v[7]);
                *(u32x4*)(dst + (size_t)(n0 + nl) * K + kb + ks) = w; }
            __syncthreads();
#undef TR_JOB
        } else if (it < IT_ROPE) {
            const int q = it - IT_CS; bf16_t* CS = (bf16_t*)(ws + WS_CS);
            for (int s = 0; s < 8; ++s) { const int idx = s * 512 + tid, l = 64 * q + (idx >> 6), cc = (idx & 63) * 8, cs = cc >> 8, c0 = cc & 255; float v[8];
#pragma unroll
                for (int e = 0; e < 8; ++e) { const int m = (l * (c0 + e)) & 255; const int id = cs ? ((m * 16 - 1024) & 4095) : (m * 16); v[e] = 4.0f * tab[id]; }
                u32x4 w; w.x = cvtpk(v[0], v[1]); w.y = cvtpk(v[2], v[3]); w.z = cvtpk(v[4], v[5]); w.w = cvtpk(v[6], v[7]);
                *(u32x4*)(CS + (size_t)l * 512 + cc) = w; }
        } else {
            float* T = (float*)(ws + WS_ROPE);
            for (int i = tid; i < 2048; i += 512) { const int pos = i >> 5, f = i & 31;
                const float inv = __builtin_amdgcn_exp2f(-(float)f * (13.287712379549449f / 32.0f));
                const float ang = (float)pos * inv, rev = ang * 0.15915494309189535f, fr = rev - rintf(rev);
                T[2 * i] = __builtin_amdgcn_cosf(fr); T[2 * i + 1] = __builtin_amdgcn_sinf(fr); }
        }
    }
}

#define XB_TMO      128
#define XB_XCNT(j)  (256  + 64 * (j))
#define XB_XSUB(j)  (1280 + 64 * (j))
#define XB_XGEN(j)  (2304 + 64 * (j))
#define XB_TOP      3328
#define XB_TOPGEN   3392
#define XB_SPIN_CAP (1u << 20)
__device__ __forceinline__ unsigned xb_ld(unsigned* p)              { return __hip_atomic_load(p, __ATOMIC_RELAXED, __HIP_MEMORY_SCOPE_AGENT); }
__device__ __forceinline__ unsigned xb_add(unsigned* p, unsigned v) { return __hip_atomic_fetch_add(p, v, __ATOMIC_RELAXED, __HIP_MEMORY_SCOPE_AGENT); }
__device__ __forceinline__ unsigned xb_xcc_id() { return (unsigned)__builtin_amdgcn_s_getreg((3 << 11) | 20) & 0xFu; }
#define XB_SPIN(cond, bar) do { unsigned _sp = 0; while (cond) { __builtin_amdgcn_s_sleep(1); \
    if ((++_sp & 255u) == 0u) { if (xb_ld(&(bar)[XB_TMO])) break; if (_sp > XB_SPIN_CAP) { atomicAdd(&(bar)[XB_TMO], 1u); break; } } } } while (0)
struct XcdBarrier { unsigned* bar; unsigned x; volatile LAS unsigned* st; };
__device__ __forceinline__ XcdBarrier xcd_barrier_post(unsigned* bar, volatile LAS unsigned* st) {
    XcdBarrier b; b.bar = bar; b.x = xb_xcc_id(); b.st = st;
    if (threadIdx.x == 0) (void)xb_add(&bar[XB_XCNT(b.x)], 1u);
    return b;
}
__device__ __forceinline__ void xcd_barrier_complete(unsigned* bar, unsigned x, unsigned& nloc, unsigned& nx) {
    const unsigned G = gridDim.x * gridDim.y * gridDim.z;
    unsigned sum, cnt, mine, sp = 0u;
    for (;;) {
        sum = 0u; cnt = 0u; mine = 0u;
#pragma unroll
        for (unsigned j = 0; j < 16; ++j) { const unsigned c = xb_ld(&bar[XB_XCNT(j)]); sum += c; cnt += (c > 0u) ? 1u : 0u; mine = (j == x) ? c : mine; }
        if (sum == G) break;
        __builtin_amdgcn_s_sleep(1);
        if ((++sp & 255u) == 0u) { if (xb_ld(&bar[XB_TMO])) break; if (sp > XB_SPIN_CAP) { atomicAdd(&bar[XB_TMO], 1u); break; } }
    }
    nloc = mine > 0u ? mine : 1u; nx = cnt > 0u ? cnt : 1u;
}
__device__ __forceinline__ void xcd_barrier(const XcdBarrier& b) {
    asm volatile("s_waitcnt vmcnt(0)" ::: "memory");
    __syncthreads();
    if (threadIdx.x == 0) {
        unsigned* bar = b.bar;
        __builtin_amdgcn_s_waitcnt(0);
        unsigned nloc = b.st[0], nx = b.st[1];
        if (nloc == 0u) { xcd_barrier_complete(bar, b.x, nloc, nx); b.st[0] = nloc; b.st[1] = nx; }
        const unsigned old = xb_add(&bar[XB_XSUB(b.x)], 1u);
        const unsigned gen = old / nloc;
        if (old + 1u == (gen + 1u) * nloc) {
            __builtin_amdgcn_fence(__ATOMIC_RELEASE, "agent");
            asm volatile("s_waitcnt vmcnt(0)" ::: "memory");
            const unsigned og = xb_add(&bar[XB_TOP], 1u);
            const unsigned tg = og / nx;
            if (og + 1u == (tg + 1u) * nx) xb_add(&bar[XB_TOPGEN], 1u);
            else XB_SPIN(xb_ld(&bar[XB_TOPGEN]) == tg, bar);
            __builtin_amdgcn_fence(__ATOMIC_ACQUIRE, "agent");
            xb_add(&bar[XB_XGEN(b.x)], 1u);
            asm volatile("s_waitcnt vmcnt(0)" ::: "memory");
        } else {
            XB_SPIN(xb_ld(&bar[XB_XGEN(b.x)]) == gen, bar);
            __builtin_amdgcn_fence(__ATOMIC_ACQUIRE, "agent");
            asm volatile("s_waitcnt vmcnt(0)" ::: "memory");
        }
    }
    __syncthreads();
}

constexpr int N_PHASES = 17;
__global__ void __launch_bounds__(512, 2) k_all(Params p, int ph_lo, int ph_hi) {
    extern __shared__ __attribute__((aligned(16))) unsigned char lds_raw[];
    LAS unsigned char* lds = (LAS unsigned char*)lds_raw;
    unsigned char* ws = p.ws;
    const int G = gridDim.x, c = blockIdx.x;
    bf16_t* X = (bf16_t*)(ws + WS_X); bf16_t* H = (bf16_t*)(ws + WS_H); const float* mod = (const float*)(ws + WS_MOD);
#define IN(k) (ph_lo <= (k) && (k) < ph_hi)
    volatile LAS unsigned* bst = (volatile LAS unsigned*)(lds + BARLDS_OFF);
    XcdBarrier xbar; xbar.bar = (unsigned*)(ws + WS_BAR); xbar.x = 0; xbar.st = bst;
    if (ph_hi - ph_lo > 1) {
        if (threadIdx.x == 0) { bst[0] = 0u; bst[1] = 0u; }
        __syncthreads();
        xbar = xcd_barrier_post((unsigned*)(ws + WS_BAR), bst);
    }
    if (ph_lo < 0) cg::this_grid().sync();
#define SEAM(k) do { if (IN(k) && IN((k) + 1)) xcd_barrier(xbar); } while (0)
    if (IN(0)) phase_prep(p, lds);
    SEAM(0);
    if (IN(1)) {
        normmod_rows(p.x, H, p.g_mix, mod, 0, MTOK, 12, 0);
        normmod_rows(p.ctx, H + (size_t)MTOK * DM, p.g_mix, mod, 0, MCTX, 30, 8);
        shiftw_rows((const bf16_t*)(ws + WS_WGU), mod, (float*)(ws + WS_SHW));
    }
    SEAM(1);
    if (IN(2)) {
        ProbPlain g{(const char*)H, (const char*)(ws + WS_WQKV), DM, DM, DM}; QkvOrder S{G, c};
        EpiQKV E{(bf16_t*)(ws + WS_Q), (bf16_t*)(ws + WS_K), (bf16_t*)(ws + WS_V), p.g_q, p.g_k, (const float*)(ws + WS_ROPE)};
        gemm_phase<EpiQKV, QkvOrder, ProbPlain>(lds, g, S, E);
    }
    SEAM(2);
    if (IN(3)) {
        const int vcu = (G % 8 == 0) ? (c % 8) * (G / 8) + c / 8 : c;
        const bf16_t* Q = (const bf16_t*)(ws + WS_Q); const bf16_t* Kc = (const bf16_t*)(ws + WS_K); const bf16_t* Vc = (const bf16_t*)(ws + WS_V); bf16_t* O = (bf16_t*)(ws + WS_O);
        float gqm = 0.f, gkm = 0.f;
        for (int i = 0; i < HD; ++i) { gqm = fmaxf(gqm, fabsf(p.g_q[i])); gkm = fmaxf(gkm, fabsf(p.g_k[i])); }
        const float mnC = -(SCALE * 1.4426950408889634f) * (float)HD * gqm * gkm;
        for (int v = vcu; v < NBATCH * NHEAD * (SEQ / 256); v += G) {
            const int grp = v >> 6, w = v & 63, b = grp >> 1, kvh = grp & 1, h = kvh * 4 + (w >> 4), qb = w & 15;
            const size_t qoff = ((size_t)(b * SEQ + qb * 256)) * DM + h * HD, koff = ((size_t)(b * NKVH + kvh) * SKV) * HD;
            attn_dense_body(Q + qoff, Kc + koff, Vc + koff, O + qoff, SKV, (char*)lds_raw, lds, mnC);
            __syncthreads();
        }
    }
    SEAM(3);
    if (IN(4)) {
        ProbPlain g{(const char*)(ws + WS_O), (const char*)(ws + WS_WO), DM, DM, DM}; StaticOrder S{MTOK / 256, DM / 256, G, c};
        EpiResB<true> E{p.x, X, mod + 2 * 1024, nullptr, H, (float*)(ws + WS_SSQ), p.g_ffn, mod + 4 * 1024};
        gemm_phase<EpiResB<true>, StaticOrder, ProbPlain>(lds, g, S, E);
    }
    SEAM(4);
    if (IN(5)) {
        ProbPlain g{(const char*)H, (const char*)(ws + WS_WGU), DM, DM, DM}; StaticOrder S{MTOK / 256, 2 * DFF / 256, G, c};
        EpiSwiGLU2 E{(bf16_t*)(ws + WS_ACT), (const float*)(ws + WS_SSQ), (const float*)(ws + WS_SHW)};
        rstd_prestep(S, (const float*)(ws + WS_SSQ), E.shw, (LAS float*)(lds + XLDS_OFF));
        gemm_phase<EpiSwiGLU2, StaticOrder, ProbPlain>(lds, g, S, E);
    }
    SEAM(5);
    if (IN(7)) {
        ProbPlain g{(const char*)(ws + WS_ACT), (const char*)(ws + WS_WD), DFF, DFF, DFF}; StaticOrder S{MTOK / 256, DM / 256, G, c};
        EpiResB<false> E{X, X, mod + 5 * 1024, nullptr, nullptr, (float*)(ws + WS_SSQ), nullptr, nullptr};
        gemm_phase<EpiResB<false>, StaticOrder, ProbPlain>(lds, g, S, E);
    }
    SEAM(7);
    if (IN(9)) phase_fft1(X, (const float*)(ws + WS_SSQ), p.g_mix + DM, mod + 9 * 6144, (bf16_t*)(ws + WS_AP), (char*)lds_raw);
    SEAM(9);
    if (IN(10)) phase_fft3((const bf16_t*)(ws + WS_AP), (bf16_t*)(ws + WS_Z), (char*)lds_raw);
    SEAM(10);
    if (IN(11)) {
        ProbCh g{(const char*)(ws + WS_Z), (const char*)(ws + WS_CS), 2048, 512, 512}; StaticOrder S{MTOK / 256, DM / 256, G, c};
        EpiBf16 E{H};
        gemm_phase<EpiBf16, StaticOrder, ProbCh>(lds, g, S, E);
    }
    SEAM(11);
    if (IN(12)) {
        ProbPlain g{(const char*)H, (const char*)(ws + WS_WF), DM, DM, DM}; StaticOrder S{MTOK / 256, DM / 256, G, c};
        EpiResB<false> E{X, X, mod + 9 * 6144 + 2 * 1024, p.b_f, (bf16_t*)(ws + WS_XG1), (float*)(ws + WS_SSQ), p.g_ffn + DM, mod + 9 * 6144 + 4 * 1024};
        gemm_phase<EpiResB<false>, StaticOrder, ProbPlain>(lds, g, S, E);
    }
    SEAM(12);
    if (IN(13)) {
        ProbPlain g{(const char*)(ws + WS_XG1), (const char*)(ws + WS_WGU) + (size_t)2 * DFF * DM * 2, DM, DM, DM}; StaticOrder S{MTOK / 256, 2 * DFF / 256, G, c};
        EpiSwiGLU2 E{(bf16_t*)(ws + WS_ACT), (const float*)(ws + WS_SSQ), (const float*)(ws + WS_SHW) + (size_t)8 * 2 * DFF};
        rstd_prestep(S, (const float*)(ws + WS_SSQ), E.shw, (LAS float*)(lds + XLDS_OFF));
        gemm_phase<EpiSwiGLU2, StaticOrder, ProbPlain>(lds, g, S, E);
    }
    SEAM(13);
    if (IN(15)) {
        ProbPlain g{(const char*)(ws + WS_ACT), (const char*)(ws + WS_WD) + (size_t)DM * DFF * 2, DFF, DFF, DFF}; StaticOrder S{MTOK / 256, DM / 256, G, c};
        EpiFinal E{X, mod + 9 * 6144 + 5 * 1024, p.g_final, p.out, (float*)(ws + WS_EXCH), (unsigned*)(ws + WS_BAR) + 3456};
        gemm_phase<EpiFinal, StaticOrder, ProbPlain>(lds, g, S, E);
    }
#undef IN
#undef SEAM
}

extern "C" void kernel_launch(void* const* d_in, const int* in_sizes, int n_in, void* d_out, int out_size, void* d_ws, size_t ws_size, hipStream_t stream) {
    static int grid = 0;
    if (grid == 0) {
        if (n_in != 17 || in_sizes[0] != MTOK * DM || out_size != MTOK * DM || ws_size < WS_END) {
            fprintf(stderr, "kernel_launch: shape/workspace mismatch: n_in %d in0 %d out %d ws %zu (need %zu)\n", n_in, n_in > 0 ? in_sizes[0] : -1, out_size, ws_size, (size_t)WS_END); grid = -1; return; }
        int dev = 0, cus = 0, per_cu = 0;
        if (hipGetDevice(&dev) != hipSuccess || hipDeviceGetAttribute(&cus, hipDeviceAttributeMultiprocessorCount, dev) != hipSuccess) { grid = -1; return; }
        if (hipFuncSetAttribute((const void*)k_all, hipFuncAttributeMaxDynamicSharedMemorySize, LDS_BYTES) != hipSuccess) { fprintf(stderr, "kernel_launch: hipFuncSetAttribute failed\n"); grid = -1; return; }
        if (hipOccupancyMaxActiveBlocksPerMultiprocessor(&per_cu, (const void*)k_all, 512, LDS_BYTES) != hipSuccess || per_cu < 1) { fprintf(stderr, "kernel_launch: occupancy query failed (%d)\n", per_cu); grid = -1; return; }
        grid = cus * per_cu;
    }
    if (grid < 0) return;
    Params p{};
    p.x = (const float*)d_in[0]; p.c = (const float*)d_in[1]; p.ctx = (const float*)d_in[2]; p.c_ctx = (const float*)d_in[3]; p.w_mod = (const float*)d_in[4]; p.b_mod = (const float*)d_in[5];
    p.g_mix = (const float*)d_in[6]; p.g_ffn = (const float*)d_in[7]; p.w_qkv = (const float*)d_in[8]; p.g_q = (const float*)d_in[9]; p.g_k = (const float*)d_in[10]; p.w_o = (const float*)d_in[11];
    p.w_f = (const float*)d_in[12]; p.b_f = (const float*)d_in[13]; p.w_gu = (const float*)d_in[14]; p.w_d = (const float*)d_in[15]; p.g_final = (const float*)d_in[16];
    p.out = (float*)d_out; p.ws = (unsigned char*)d_ws;
    if (hipMemsetAsync((unsigned char*)d_ws + WS_BAR, 0, BAR_BYTES, stream) != hipSuccess) { fprintf(stderr, "kernel_launch: memset of the barrier words failed\n"); return; }
#if MK_COOP
    int lo = 0, hi = N_PHASES;
    void* args[] = {&p, &lo, &hi};
    hipError_t e = hipLaunchCooperativeKernel((const void*)k_all, dim3(grid), dim3(512), args, LDS_BYTES, stream);
    if (e != hipSuccess) fprintf(stderr, "kernel_launch: cooperative launch failed: %s (grid %d)\n", hipGetErrorString(e), grid);
#else
    for (int ph = 0; ph < N_PHASES; ++ph) hipLaunchKernelGGL(k_all, dim3(grid), dim3(512), LDS_BYTES, stream, p, ph, ph + 1);
    hipError_t e = hipPeekAtLastError();
    if (e != hipSuccess) fprintf(stderr, "kernel_launch: launch failed: %s\n", hipGetErrorString(e));
#endif
}
```

```cpp
#include <hip/hip_runtime.h>
#include <hip/hip_cooperative_groups.h>
#include <cstdio>
#include <cstdint>
namespace cg = cooperative_groups;

#ifndef MK_COOP
#define MK_COOP 1
#endif

#define LAS __attribute__((address_space(3)))
typedef unsigned short bf16_t;
typedef short bf16x8 __attribute__((ext_vector_type(8)));
typedef short s16x4 __attribute__((ext_vector_type(4)));
typedef float f32x4 __attribute__((ext_vector_type(4)));
typedef float f32x16 __attribute__((ext_vector_type(16)));
typedef unsigned u32x4 __attribute__((ext_vector_type(4)));
typedef unsigned u32x2 __attribute__((ext_vector_type(2)));

constexpr int DM = 1024, NBATCH = 8, SEQ = 4096, CTXL = 256, DFF = 2816, NHEAD = 8, NKVH = 2, HD = 128, SKV = SEQ + CTXL;
constexpr int MTOK = NBATCH * SEQ, MCTX = NBATCH * CTXL, MALL = MTOK + MCTX, NQKV = DM + 2 * NKVH * HD;
constexpr float EPSN = 1e-6f;

constexpr size_t al256(size_t x) { return (x + 255) / 256 * 256; }
constexpr size_t WS_WQKV = 0;
constexpr size_t WS_WO   = WS_WQKV + (size_t)NQKV * DM * 2;
constexpr size_t WS_WF   = WS_WO + (size_t)DM * DM * 2;
constexpr size_t WS_WGU  = WS_WF + (size_t)DM * DM * 2;
constexpr size_t WS_WD   = WS_WGU + (size_t)2 * 2 * DFF * DM * 2;
constexpr size_t WS_CS   = WS_WD + (size_t)2 * DM * DFF * 2;
constexpr size_t WS_MOD  = WS_CS + (size_t)512 * 256 * 2;
constexpr size_t WS_ROPE = WS_MOD + (size_t)2 * 9 * 6144 * 4;
constexpr size_t WS_H    = al256(WS_ROPE + 64 * 32 * 2 * 4);
constexpr size_t WS_X    = WS_H + (size_t)MALL * DM * 2;
constexpr size_t WS_R    = WS_X + (size_t)MTOK * DM * 4;
constexpr size_t WS_Q    = WS_R;
constexpr size_t WS_K    = WS_Q + (size_t)MTOK * DM * 2;
constexpr size_t WS_V    = WS_K + (size_t)NBATCH * NKVH * SKV * HD * 2;
constexpr size_t WS_O    = WS_V + (size_t)NBATCH * NKVH * SKV * HD * 2;
constexpr size_t WS_ACT  = WS_R;
constexpr size_t WS_AP   = WS_R;
constexpr size_t WS_Z    = WS_R + (size_t)MTOK * DM * 2 * 2;
constexpr size_t WS_BAR  = WS_Z + (size_t)MTOK * DM * 2 * 2;
constexpr size_t BAR_BYTES = 16384;
constexpr size_t WS_SSQ  = WS_BAR + 16384;
constexpr size_t WS_SHW  = WS_SSQ + (size_t)MTOK * 16 * 4;
constexpr size_t WS_XG1  = WS_R + (size_t)192 * 1024 * 1024;
constexpr size_t WS_EXCH = WS_SHW + (size_t)2 * 8 * 2 * DFF * 4;
constexpr size_t WS_END  = WS_EXCH + (size_t)MTOK * 4 * 4;
static_assert(WS_XG1 >= WS_ACT + (size_t)MTOK * DFF * 2 && WS_XG1 + (size_t)MTOK * DM * 2 <= WS_BAR && WS_O + (size_t)MTOK * DM * 2 <= WS_END && WS_ACT + (size_t)MTOK * DFF * 2 <= WS_END && WS_END <= (size_t)536870912, "union region");

constexpr int STAGE_BYTES = 131072, XLDS_OFF = STAGE_BYTES, BARLDS_OFF = STAGE_BYTES + 24576, LDS_BYTES = STAGE_BYTES + 24576 + 16;

struct Params {
    const float *x, *c, *ctx, *c_ctx, *w_mod, *b_mod, *g_mix, *g_ffn, *w_qkv, *g_q, *g_k, *w_o, *w_f, *b_f, *w_gu, *w_d, *g_final;
    float* out; unsigned char* ws;
};

typedef __bf16 bf16x2_n __attribute__((ext_vector_type(2)));
typedef float f32x2_n __attribute__((ext_vector_type(2)));
__device__ __forceinline__ unsigned cvtpk(float lo, float hi) { f32x2_n v = {lo, hi}; bf16x2_n b = __builtin_convertvector(v, bf16x2_n); return *reinterpret_cast<unsigned*>(&b); }

constexpr int BM = 256, BK = 64, HALF = 128, HTB = HALF * BK * 2, NXCD = 8, WGM = 8;
__host__ __device__ __forceinline__ int lds_byte(int r, int c) { const int st = (r >> 4) * 2 + (c >> 5), rr = r & 15, cc = c & 31, ob = rr * 64 + cc * 2; return st * 1024 + (ob ^ (((ob >> 9) & 1) << 5)); }
__host__ __device__ __forceinline__ void stage_rc(int b, int& R, int& C) { const int st = b / 1024, sb = b % 1024, swz = sb ^ (((sb >> 9) & 1) << 5); R = (st >> 1) * 16 + swz / 64; C = (st & 1) * 32 + (swz % 64) / 2; }
__host__ __device__ __forceinline__ int perm32(int rho) { const int n = rho >> 4, i = rho & 15; return 8 * (i >> 2) + 4 * n + (i & 3); }

struct Unit { int pm, pn; };
__device__ __forceinline__ void tile_map(int wgid, int nM, int nN, Unit& u) {
    const int nwg = nM * nN;
    { const int q = nwg / NXCD, r = nwg % NXCD, xcd = wgid % NXCD, off = wgid / NXCD; wgid = (xcd < r ? xcd * (q + 1) : r * (q + 1) + (xcd - r) * q) + off; }
    const int nig = WGM * nN, gid = wgid / nig, fm = gid * WGM, gsz = (nM - fm) < WGM ? (nM - fm) : WGM;
    u.pm = fm + ((wgid % nig) % gsz); u.pn = (wgid % nig) / gsz;
}
struct StaticOrder {
    int nM, nN, G, c;
    __device__ __forceinline__ bool next(int i, Unit& u) const { const long L = (long)i * G + c; if (L >= (long)nM * nN) return false; tile_map((int)L, nM, nN, u); return true; }
};
struct QkvOrder {
    int G, c;
    __device__ __forceinline__ bool next(int i, Unit& u) const {
        const long L = (long)i * G + c;
        if (L < 768) { tile_map((int)L, 128, 6, u); return true; }
        if (L < 784) { const int e = (int)L - 768; u.pm = 128 + (e >> 1); u.pn = 4 + (e & 1); return true; }
        return false;
    }
};
struct ProbPlain {
    const char* A; const char* B; unsigned lda, ldb; int K;
    __device__ __forceinline__ const char* a(const Unit& u) const { return A + (size_t)u.pm * 256 * lda * 2; }
    __device__ __forceinline__ const char* b(const Unit& u) const { return B + (size_t)u.pn * 256 * ldb * 2; }
};
struct ProbCh {
    const char* A; const char* B; unsigned lda, ldb; int K;
    __device__ __forceinline__ const char* a(const Unit& u) const { return A + ((size_t)u.pm * 256 * 2048 + (size_t)u.pn * 512) * 2; }
    __device__ __forceinline__ const char* b(const Unit&) const { return B; }
};

template <class Epi, class Sched, class Prob>
__device__ __forceinline__ void gemm_phase(LAS unsigned char* lds, const Prob g, const Sched& S, const Epi& E) {
    const int tid = threadIdx.x, wid = __builtin_amdgcn_readfirstlane(tid >> 6), lane = tid & 63, wr = wid >> 2, wc = wid & 3, fr = lane & 15, fq = lane >> 4;
    const int nt = g.K / BK;
    unsigned voffA[2], voffB[2];
#pragma unroll
    for (int i = 0; i < 2; ++i) { int R, C; stage_rc(tid * 16 + i * 8192, R, C); const int Rb = Epi::PERM ? ((R & ~31) + perm32(R & 31)) : R;
        voffA[i] = (unsigned)(R * g.lda + C) * 2u; voffB[i] = (unsigned)(Rb * g.ldb + C) * 2u; }
    const size_t kstep = (size_t)(BK * 2);
    const size_t hstepA = (size_t)HALF * g.lda * 2, hstepB = (size_t)HALF * g.ldb * 2;
    const unsigned ldsw = (unsigned)wid * 1024u;
    const int aoff = lds_byte(wr * 64 + fr, fq * 8), boff = lds_byte(wc * 32 + fr, fq * 8);
    LAS float* xlds = (LAS float*)(lds + XLDS_OFF);
#define PG8_SA(b, h) (((b) * 2 + (h)) * HTB)
#define PG8_SB(b, h) ((4 + (b) * 2 + (h)) * HTB)
#define PG8_STAGE(bufoff, gbase, voff) do { _Pragma("unroll") for (int _i = 0; _i < 2; ++_i) \
        __builtin_amdgcn_global_load_lds((const unsigned*)((const char*)(gbase) + (voff)[_i]), (LAS unsigned*)(lds + (bufoff) + ldsw + _i * 8192), 16, 0, 0); } while (0)
#define PG8_LDA(dst, b, h) do { _Pragma("unroll") for (int m = 0; m < 4; ++m) _Pragma("unroll") for (int k = 0; k < 2; ++k) dst[m][k] = *(const LAS bf16x8*)(lds + PG8_SA(b, h) + aoff + m * 2048 + k * 1024); } while (0)
#define PG8_LDB(dst, b, h) do { _Pragma("unroll") for (int n = 0; n < 2; ++n) _Pragma("unroll") for (int k = 0; k < 2; ++k) dst[n][k] = *(const LAS bf16x8*)(lds + PG8_SB(b, h) + boff + n * 2048 + k * 1024); } while (0)
#define PG8_MMA(ai, bj, At, Bt) do { __builtin_amdgcn_s_setprio(1); _Pragma("unroll") for (int m = 0; m < 4; ++m) _Pragma("unroll") for (int n = 0; n < 2; ++n) _Pragma("unroll") for (int k = 0; k < 2; ++k) \
        acc[ai][bj][m][n] = __builtin_amdgcn_mfma_f32_16x16x32_bf16(Bt[n][k], At[m][k], acc[ai][bj][m][n], 0, 0, 0); __builtin_amdgcn_s_setprio(0); } while (0)
#define PG8_WAIT_V(n) asm volatile("s_waitcnt vmcnt(" #n ")" ::: "memory")
#define PG8_WAIT_L(n) asm volatile("s_waitcnt lgkmcnt(" #n ")" ::: "memory")
#define PG8_BAR __builtin_amdgcn_s_barrier()
#define PG8_SCHED __builtin_amdgcn_sched_barrier(0)
    Unit cur, nxt; int ui = 0;
    if (!S.next(0, cur)) return;
    f32x4 acc[2][2][4][2];
#pragma unroll
    for (int a = 0; a < 2; ++a)
#pragma unroll
        for (int b = 0; b < 2; ++b)
#pragma unroll
            for (int m = 0; m < 4; ++m)
#pragma unroll
                for (int n = 0; n < 2; ++n) acc[a][b][m][n] = (f32x4){0.f, 0.f, 0.f, 0.f};
    bf16x8 At[4][2], B0[2][2], B1[2][2];
    const char* cA = g.a(cur); const char* cB = g.b(cur);
    PG8_STAGE(PG8_SB(0, 0), cB, voffB); PG8_STAGE(PG8_SB(0, 1), cB + hstepB, voffB); PG8_STAGE(PG8_SA(0, 0), cA, voffA); PG8_STAGE(PG8_SA(0, 1), cA + hstepA, voffA);
    if (wr == 1) PG8_BAR;
    PG8_WAIT_V(2); PG8_BAR;
    PG8_STAGE(PG8_SB(1, 0), cB + kstep, voffB); PG8_STAGE(PG8_SA(1, 0), cA + kstep, voffA); PG8_STAGE(PG8_SB(1, 1), cB + hstepB + kstep, voffB);
    PG8_WAIT_V(6); PG8_BAR;
    for (;;) {
        const bool has_next = S.next(ui + 1, nxt);
        const char* nA = has_next ? g.a(nxt) : cA; const char* nB = has_next ? g.b(nxt) : cB;
#pragma unroll 1
        for (int t = 0; t < nt; t += 2) {
            const bool last = (t == nt - 2);
            const char* a1 = cA + (size_t)(t + 1) * kstep;
            const char* a2 = last ? nA : cA + (size_t)(t + 2) * kstep; const char* b2 = last ? nB : cB + (size_t)(t + 2) * kstep;
            const char* a3 = a2 + kstep; const char* b3 = b2 + kstep;
            PG8_LDB(B0, 0, 0); PG8_LDB(B1, 0, 1); PG8_SCHED; PG8_LDA(At, 0, 0); PG8_STAGE(PG8_SA(1, 1), a1 + hstepA, voffA);
            PG8_WAIT_V(8); PG8_WAIT_L(0); PG8_BAR; PG8_MMA(0, 0, At, B0); PG8_MMA(0, 1, At, B1); PG8_BAR; PG8_SCHED;
            PG8_LDA(At, 0, 1); PG8_STAGE(PG8_SB(0, 0), b2, voffB); PG8_STAGE(PG8_SB(0, 1), b2 + hstepB, voffB); PG8_STAGE(PG8_SA(0, 0), a2, voffA);
            PG8_WAIT_V(8); PG8_WAIT_L(0); PG8_BAR; PG8_MMA(1, 0, At, B0); PG8_MMA(1, 1, At, B1); PG8_BAR; PG8_SCHED;
            PG8_LDB(B0, 1, 0); PG8_LDB(B1, 1, 1); PG8_SCHED; PG8_LDA(At, 1, 0); PG8_STAGE(PG8_SA(0, 1), a2 + hstepA, voffA);
            PG8_WAIT_V(8); PG8_WAIT_L(0); PG8_BAR; PG8_MMA(0, 0, At, B0); PG8_MMA(0, 1, At, B1); PG8_BAR; PG8_SCHED;
            PG8_LDA(At, 1, 1); PG8_STAGE(PG8_SB(1, 0), b3, voffB); PG8_STAGE(PG8_SB(1, 1), b3 + hstepB, voffB); PG8_STAGE(PG8_SA(1, 0), a3, voffA);
            PG8_WAIT_V(8); PG8_WAIT_L(0); PG8_BAR; PG8_MMA(1, 0, At, B0); PG8_MMA(1, 1, At, B1); PG8_BAR; PG8_SCHED;
        }
        if (wr == 0) PG8_BAR;
        E(acc, cur, wr, wc, fr, fq, xlds, ui);
        if (!has_next) break;
#pragma unroll
        for (int a = 0; a < 2; ++a)
#pragma unroll
            for (int b = 0; b < 2; ++b)
#pragma unroll
                for (int m = 0; m < 4; ++m)
#pragma unroll
                    for (int n = 0; n < 2; ++n) acc[a][b][m][n] = (f32x4){0.f, 0.f, 0.f, 0.f};
        cur = nxt; cA = nA; cB = nB; ++ui;
        if (wr == 1) PG8_BAR;
    }
    PG8_WAIT_V(0);
    PG8_BAR;
#undef PG8_SA
#undef PG8_SB
#undef PG8_STAGE
#undef PG8_LDA
#undef PG8_LDB
#undef PG8_MMA
#undef PG8_WAIT_V
#undef PG8_WAIT_L
#undef PG8_BAR
#undef PG8_SCHED
}

struct EpiResid {
    static constexpr bool PERM = false;
    const float* xin; float* xout; const float* gate; const float* bias;
    __device__ __forceinline__ void operator()(const f32x4 (&acc)[2][2][4][2], const Unit& u, int wr, int wc, int fr, int fq, LAS float*, int) const {
        const int row0 = u.pm * BM + wr * 64 + fr, col0 = u.pn * BM + wc * 32 + 4 * fq;
        const float* gp = gate + (size_t)((u.pm * BM) >> 12) * 6144 + col0;
        f32x4 gv[2][2], bv[2][2];
#pragma unroll
        for (int bj = 0; bj < 2; ++bj)
#pragma unroll
            for (int n = 0; n < 2; ++n) { gv[bj][n] = *(const f32x4*)(gp + bj * HALF + n * 16); bv[bj][n] = bias ? *(const f32x4*)(bias + col0 + bj * HALF + n * 16) : (f32x4){0.f, 0.f, 0.f, 0.f}; }
#pragma unroll
        for (int ai = 0; ai < 2; ++ai)
#pragma unroll
            for (int m = 0; m < 4; ++m) { const size_t off = (size_t)(row0 + ai * HALF + m * 16) * DM + col0;
#pragma unroll
                for (int bj = 0; bj < 2; ++bj)
#pragma unroll
                    for (int n = 0; n < 2; ++n) { const f32x4 xv = *(const f32x4*)(xin + off + bj * HALF + n * 16);
                        *(f32x4*)(xout + off + bj * HALF + n * 16) = xv + gv[bj][n] * (acc[ai][bj][m][n] + bv[bj][n]); } }
    }
};
__device__ __forceinline__ float silu_f(float g) { return g * __builtin_amdgcn_rcpf(1.0f + __expf(-g)); }
struct EpiSwiGLU {
    static constexpr bool PERM = true;
    bf16_t* act;
    __device__ __forceinline__ void operator()(const f32x4 (&acc)[2][2][4][2], const Unit& u, int wr, int wc, int fr, int fq, LAS float*, int) const {
        const int row0 = u.pm * BM + wr * 64 + fr, col0 = u.pn * HALF + wc * 32 + 8 * fq;
#pragma unroll
        for (int ai = 0; ai < 2; ++ai)
#pragma unroll
            for (int m = 0; m < 4; ++m) {
                const f32x4 g0 = acc[ai][0][m][0], g1 = acc[ai][0][m][1], u0 = acc[ai][1][m][0], u1 = acc[ai][1][m][1];
                u32x4 w; w.x = cvtpk(silu_f(g0[0]) * u0[0], silu_f(g0[1]) * u0[1]); w.y = cvtpk(silu_f(g0[2]) * u0[2], silu_f(g0[3]) * u0[3]);
                w.z = cvtpk(silu_f(g1[0]) * u1[0], silu_f(g1[1]) * u1[1]); w.w = cvtpk(silu_f(g1[2]) * u1[2], silu_f(g1[3]) * u1[3]);
                *(u32x4*)(act + (size_t)(row0 + ai * HALF + m * 16) * DFF + col0) = w; }
    }
};
struct EpiResidXg {
    static constexpr bool PERM = false;
    const float* xin; float* xout; const float* gate; const float* bias; bf16_t* xg; float* ssq; const float* gnext; const float* scale;
    __device__ __forceinline__ void operator()(const f32x4 (&acc)[2][2][4][2], const Unit& u, int wr, int wc, int fr, int fq, LAS float*, int) const {
        const int row0 = u.pm * BM + wr * 64 + fr, col0 = u.pn * BM + wc * 32 + 4 * fq, b = (u.pm * BM) >> 12;
        const float* gp = gate + (size_t)b * 6144 + col0; const float* sp = scale + (size_t)b * 6144 + col0;
        f32x4 gv[2][2], bv[2][2], gs[2][2];
#pragma unroll
        for (int bj = 0; bj < 2; ++bj)
#pragma unroll
            for (int n = 0; n < 2; ++n) { gv[bj][n] = *(const f32x4*)(gp + bj * HALF + n * 16); bv[bj][n] = bias ? *(const f32x4*)(bias + col0 + bj * HALF + n * 16) : (f32x4){0.f, 0.f, 0.f, 0.f};
                gs[bj][n] = *(const f32x4*)(gnext + col0 + bj * HALF + n * 16) * (*(const f32x4*)(sp + bj * HALF + n * 16) + 1.0f); }
#pragma unroll
        for (int ai = 0; ai < 2; ++ai)
#pragma unroll
            for (int m = 0; m < 4; ++m) { const int row = row0 + ai * HALF + m * 16; const size_t off = (size_t)row * DM + col0; float s = 0.f;
#pragma unroll
                for (int bj = 0; bj < 2; ++bj)
#pragma unroll
                    for (int n = 0; n < 2; ++n) { const f32x4 xv = *(const f32x4*)(xin + off + bj * HALF + n * 16);
                        const f32x4 y = xv + gv[bj][n] * (acc[ai][bj][m][n] + bv[bj][n]);
                        *(f32x4*)(xout + off + bj * HALF + n * 16) = y;
                        s += (y[0] * y[0] + y[1] * y[1]) + (y[2] * y[2] + y[3] * y[3]);
                        const f32x4 z = y * gs[bj][n]; u32x2 w; w.x = cvtpk(z[0], z[1]); w.y = cvtpk(z[2], z[3]);
                        *(u32x2*)(xg + off + bj * HALF + n * 16) = w; }
                s += __shfl_xor(s, 16); s += __shfl_xor(s, 32);
                if (fq == 0) ssq[(size_t)row * 16 + u.pn * 4 + wc] = s; }
    }
};
struct EpiResidLast {
    static constexpr bool PERM = false;
    const float* xin; const float* gate; bf16_t* xb; float* ssq;
    __device__ __forceinline__ void operator()(const f32x4 (&acc)[2][2][4][2], const Unit& u, int wr, int wc, int fr, int fq, LAS float*, int) const {
        const int row0 = u.pm * BM + wr * 64 + fr, col0 = u.pn * BM + wc * 32 + 4 * fq;
        const float* gp = gate + (size_t)((u.pm * BM) >> 12) * 6144 + col0;
        f32x4 gv[2][2];
#pragma unroll
        for (int bj = 0; bj < 2; ++bj)
#pragma unroll
            for (int n = 0; n < 2; ++n) gv[bj][n] = *(const f32x4*)(gp + bj * HALF + n * 16);
#pragma unroll
        for (int ai = 0; ai < 2; ++ai)
#pragma unroll
            for (int m = 0; m < 4; ++m) { const int row = row0 + ai * HALF + m * 16; const size_t off = (size_t)row * DM + col0; float s = 0.f;
#pragma unroll
                for (int bj = 0; bj < 2; ++bj)
#pragma unroll
                    for (int n = 0; n < 2; ++n) { const f32x4 xv = *(const f32x4*)(xin + off + bj * HALF + n * 16);
                        const f32x4 y = xv + gv[bj][n] * acc[ai][bj][m][n];
                        s += (y[0] * y[0] + y[1] * y[1]) + (y[2] * y[2] + y[3] * y[3]);
                        u32x2 w; w.x = cvtpk(y[0], y[1]); w.y = cvtpk(y[2], y[3]);
                        *(u32x2*)(xb + off + bj * HALF + n * 16) = w; }
                s += __shfl_xor(s, 16); s += __shfl_xor(s, 32);
                if (fq == 0) ssq[(size_t)row * 16 + u.pn * 4 + wc] = s; }
    }
};
template <bool XIN_F32> struct EpiResB {
    static constexpr bool PERM = true;
    const void* xin; bf16_t* xout; const float* gate; const float* bias; bf16_t* xg; float* ssq; const float* gnext; const float* scale;
    __device__ __forceinline__ void operator()(const f32x4 (&acc)[2][2][4][2], const Unit& u, int wr, int wc, int fr, int fq, LAS float*, int) const {
        const int row0 = u.pm * BM + wr * 64 + fr, col0 = u.pn * BM + wc * 32 + 8 * fq, b = (u.pm * BM) >> 12;
        const float* gp = gate + (size_t)b * 6144 + col0;
        f32x4 gv[2][2], bv[2][2], gs[2][2];
#pragma unroll
        for (int bj = 0; bj < 2; ++bj)
#pragma unroll
            for (int n = 0; n < 2; ++n) { gv[bj][n] = *(const f32x4*)(gp + bj * HALF + n * 4); bv[bj][n] = bias ? *(const f32x4*)(bias + col0 + bj * HALF + n * 4) : (f32x4){0.f, 0.f, 0.f, 0.f};
                gs[bj][n] = xg ? *(const f32x4*)(gnext + col0 + bj * HALF + n * 4) * (*(const f32x4*)(scale + (size_t)b * 6144 + col0 + bj * HALF + n * 4) + 1.0f) : (f32x4){0.f, 0.f, 0.f, 0.f}; }
#pragma unroll
        for (int ai = 0; ai < 2; ++ai)
#pragma unroll
            for (int m = 0; m < 4; ++m) { const int row = row0 + ai * HALF + m * 16; const size_t off = (size_t)row * DM + col0; float s = 0.f;
#pragma unroll
                for (int bj = 0; bj < 2; ++bj) { f32x4 x0, x1;
                    if (XIN_F32) { const float* xp = (const float*)xin + off + bj * HALF; x0 = *(const f32x4*)xp; x1 = *(const f32x4*)(xp + 4); }
                    else { const u32x4 r = *(const u32x4*)((const bf16_t*)xin + off + bj * HALF);
                        x0 = (f32x4){__uint_as_float(r[0] << 16), __uint_as_float(r[0] & 0xffff0000u), __uint_as_float(r[1] << 16), __uint_as_float(r[1] & 0xffff0000u)};
                        x1 = (f32x4){__uint_as_float(r[2] << 16), __uint_as_float(r[2] & 0xffff0000u), __uint_as_float(r[3] << 16), __uint_as_float(r[3] & 0xffff0000u)}; }
                    const f32x4 y0 = x0 + gv[bj][0] * (acc[ai][bj][m][0] + bv[bj][0]), y1 = x1 + gv[bj][1] * (acc[ai][bj][m][1] + bv[bj][1]);
                    s += ((y0[0] * y0[0] + y0[1] * y0[1]) + (y0[2] * y0[2] + y0[3] * y0[3])) + ((y1[0] * y1[0] + y1[1] * y1[1]) + (y1[2] * y1[2] + y1[3] * y1[3]));
                    u32x4 w; w.x = cvtpk(y0[0], y0[1]); w.y = cvtpk(y0[2], y0[3]); w.z = cvtpk(y1[0], y1[1]); w.w = cvtpk(y1[2], y1[3]);
                    *(u32x4*)(xout + off + bj * HALF) = w;
                    if (xg) { const f32x4 z0 = y0 * gs[bj][0], z1 = y1 * gs[bj][1];
                        u32x4 v; v.x = cvtpk(z0[0], z0[1]); v.y = cvtpk(z0[2], z0[3]); v.z = cvtpk(z1[0], z1[1]); v.w = cvtpk(z1[2], z1[3]);
                        *(u32x4*)(xg + off + bj * HALF) = v; } }
                if (ssq) { s += __shfl_xor(s, 16); s += __shfl_xor(s, 32);
                    if (fq == 0) ssq[(size_t)row * 16 + u.pn * 4 + wc] = s; } }
    }
};
struct EpiFinal {
    static constexpr bool PERM = true;
    const bf16_t* xin; const float* gate; const float* gfin; float* out; float* exch; unsigned* cnt;
    __device__ __forceinline__ void operator()(const f32x4 (&acc)[2][2][4][2], const Unit& u, int wr, int wc, int fr, int fq, LAS float* xs, int) const {
        const int rl0 = wr * 64 + fr, col0 = u.pn * BM + wc * 32 + 8 * fq, b = (u.pm * BM) >> 12, t = threadIdx.x;
        const float* gp = gate + (size_t)b * 6144 + col0;
        f32x4 gv[2][2];
#pragma unroll
        for (int bj = 0; bj < 2; ++bj)
#pragma unroll
            for (int n = 0; n < 2; ++n) gv[bj][n] = *(const f32x4*)(gp + bj * HALF + n * 4);
        f32x4 y[2][4][2][2];
#pragma unroll
        for (int ai = 0; ai < 2; ++ai)
#pragma unroll
            for (int m = 0; m < 4; ++m) { const int rl = ai * HALF + rl0 + m * 16; const size_t off = (size_t)(u.pm * BM + rl) * DM + col0; float s = 0.f;
#pragma unroll
                for (int bj = 0; bj < 2; ++bj) { const u32x4 r = *(const u32x4*)(xin + off + bj * HALF);
                    const f32x4 x0 = (f32x4){__uint_as_float(r[0] << 16), __uint_as_float(r[0] & 0xffff0000u), __uint_as_float(r[1] << 16), __uint_as_float(r[1] & 0xffff0000u)};
                    const f32x4 x1 = (f32x4){__uint_as_float(r[2] << 16), __uint_as_float(r[2] & 0xffff0000u), __uint_as_float(r[3] << 16), __uint_as_float(r[3] & 0xffff0000u)};
                    const f32x4 y0 = x0 + gv[bj][0] * acc[ai][bj][m][0], y1 = x1 + gv[bj][1] * acc[ai][bj][m][1];
                    y[ai][m][bj][0] = y0; y[ai][m][bj][1] = y1;
                    s += ((y0[0] * y0[0] + y0[1] * y0[1]) + (y0[2] * y0[2] + y0[3] * y0[3])) + ((y1[0] * y1[0] + y1[1] * y1[1]) + (y1[2] * y1[2] + y1[3] * y1[3])); }
                s += __shfl_xor(s, 16); s += __shfl_xor(s, 32);
                if (fq == 0) xs[rl * 4 + wc] = s; }
        asm volatile("s_waitcnt lgkmcnt(0)" ::: "memory"); __builtin_amdgcn_s_barrier(); asm volatile("" ::: "memory");
        if (t < 256) { const f32x4 pr = *(const LAS f32x4*)(xs + t * 4);
            __hip_atomic_store(exch + ((size_t)u.pm * BM + t) * 4 + u.pn, (pr[0] + pr[1]) + (pr[2] + pr[3]), __ATOMIC_RELAXED, __HIP_MEMORY_SCOPE_AGENT); }
        asm volatile("s_waitcnt vmcnt(0)" ::: "memory"); __builtin_amdgcn_s_barrier(); asm volatile("" ::: "memory");
        if (t == 0) { unsigned* cp = cnt + u.pm * 4;
            __builtin_amdgcn_fence(__ATOMIC_RELEASE, "agent");
            (void)__hip_atomic_fetch_add(cp, 1u, __ATOMIC_RELAXED, __HIP_MEMORY_SCOPE_AGENT);
            unsigned sp = 0u;
            while (__hip_atomic_load(cp, __ATOMIC_RELAXED, __HIP_MEMORY_SCOPE_AGENT) < 4u) { __builtin_amdgcn_s_sleep(1); if (++sp > (1u << 22)) break; }
            __builtin_amdgcn_fence(__ATOMIC_ACQUIRE, "agent");
            asm volatile("s_waitcnt vmcnt(0)" ::: "memory"); }
        __builtin_amdgcn_s_barrier(); asm volatile("" ::: "memory");
        if (t < 256) { const float* ep = exch + ((size_t)u.pm * BM + t) * 4; float tot = 0.f;
#pragma unroll
            for (int q = 0; q < 4; ++q) tot += __hip_atomic_load(ep + q, __ATOMIC_RELAXED, __HIP_MEMORY_SCOPE_AGENT);
            xs[1024 + t] = __builtin_amdgcn_rsqf(tot * (1.0f / DM) + EPSN); }
        asm volatile("s_waitcnt lgkmcnt(0)" ::: "memory"); __builtin_amdgcn_s_barrier(); asm volatile("" ::: "memory");
        f32x4 gf[2][2];
#pragma unroll
        for (int bj = 0; bj < 2; ++bj)
#pragma unroll
            for (int n = 0; n < 2; ++n) gf[bj][n] = *(const f32x4*)(gfin + col0 + bj * HALF + n * 4);
#pragma unroll
        for (int ai = 0; ai < 2; ++ai)
#pragma unroll
            for (int m = 0; m < 4; ++m) { const int rl = ai * HALF + rl0 + m * 16; const float rs = xs[1024 + rl]; float* op = out + (size_t)(u.pm * BM + rl) * DM + col0;
#pragma unroll
                for (int bj = 0; bj < 2; ++bj) { *(f32x4*)(op + bj * HALF) = y[ai][m][bj][0] * rs * gf[bj][0]; *(f32x4*)(op + bj * HALF + 4) = y[ai][m][bj][1] * rs * gf[bj][1]; } }
    }
};
struct EpiSwiGLU2 {
    static constexpr bool PERM = true;
    bf16_t* act; const float* ssq; const float* shw;
    __device__ __forceinline__ void operator()(const f32x4 (&acc)[2][2][4][2], const Unit& u, int wr, int wc, int fr, int fq, LAS float* xs, int ui) const {
        xs += ui * 256;
        const int rl0 = wr * 64 + fr, row0 = u.pm * BM + rl0, col0 = u.pn * HALF + wc * 32 + 8 * fq, b = (u.pm * BM) >> 12;
        const LAS float* sw = xs + 3072 + wc * 32 + 8 * fq;
        const f32x4 sg0 = *(const LAS f32x4*)sw, sg1 = *(const LAS f32x4*)(sw + 4), su0 = *(const LAS f32x4*)(sw + HALF), su1 = *(const LAS f32x4*)(sw + HALF + 4);
#pragma unroll
        for (int ai = 0; ai < 2; ++ai)
#pragma unroll
            for (int m = 0; m < 4; ++m) { const float rs = xs[ai * HALF + rl0 + m * 16];
                const f32x4 g0 = acc[ai][0][m][0] * rs + sg0, g1 = acc[ai][0][m][1] * rs + sg1, u0 = acc[ai][1][m][0] * rs + su0, u1 = acc[ai][1][m][1] * rs + su1;
                u32x4 w; w.x = cvtpk(silu_f(g0[0]) * u0[0], silu_f(g0[1]) * u0[1]); w.y = cvtpk(silu_f(g0[2]) * u0[2], silu_f(g0[3]) * u0[3]);
                w.z = cvtpk(silu_f(g1[0]) * u1[0], silu_f(g1[1]) * u1[1]); w.w = cvtpk(silu_f(g1[2]) * u1[2], silu_f(g1[3]) * u1[3]);
                *(u32x4*)(act + (size_t)(row0 + ai * HALF + m * 16) * DFF + col0) = w; }
    }
};
struct EpiBf16 {
    static constexpr bool PERM = true;
    bf16_t* O;
    __device__ __forceinline__ void operator()(const f32x4 (&acc)[2][2][4][2], const Unit& u, int wr, int wc, int fr, int fq, LAS float*, int) const {
        const int row0 = u.pm * BM + wr * 64 + fr, col0 = u.pn * BM + wc * 32 + 8 * fq;
#pragma unroll
        for (int ai = 0; ai < 2; ++ai)
#pragma unroll
            for (int m = 0; m < 4; ++m) { bf16_t* rowp = O + (size_t)(row0 + ai * HALF + m * 16) * DM + col0;
#pragma unroll
                for (int bj = 0; bj < 2; ++bj) { const f32x4 v0 = acc[ai][bj][m][0], v1 = acc[ai][bj][m][1];
                    u32x4 w; w.x = cvtpk(v0[0], v0[1]); w.y = cvtpk(v0[2], v0[3]); w.z = cvtpk(v1[0], v1[1]); w.w = cvtpk(v1[2], v1[3]);
                    *(u32x4*)(rowp + bj * HALF) = w; } }
    }
};
struct EpiQKV {
    static constexpr bool PERM = true;
    bf16_t* Q; bf16_t* Kc; bf16_t* Vc; const float* gq; const float* gk; const float* rope;
    __device__ __forceinline__ void operator()(const f32x4 (&acc)[2][2][4][2], const Unit& u, int wr, int wc, int fr, int fq, LAS float* xs, int ui) const {
        const int rl0 = wr * 64 + fr, cl = wc * 32 + 8 * fq;
        if (u.pn == 5) {
#pragma unroll
            for (int ai = 0; ai < 2; ++ai)
#pragma unroll
                for (int m = 0; m < 4; ++m) { const int R = u.pm * BM + ai * HALF + rl0 + m * 16; int b, pos;
                    if (R < MTOK) { b = R >> 12; pos = R & 4095; } else { const int r2 = R - MTOK; b = r2 >> 8; pos = SEQ + (r2 & 255); }
#pragma unroll
                    for (int bj = 0; bj < 2; ++bj) { const f32x4 v0 = acc[ai][bj][m][0], v1 = acc[ai][bj][m][1];
                        u32x4 w; w.x = cvtpk(v0[0], v0[1]); w.y = cvtpk(v0[2], v0[3]); w.z = cvtpk(v1[0], v1[1]); w.w = cvtpk(v1[2], v1[3]);
                        *(u32x4*)(Vc + ((size_t)(b * NKVH + bj) * SKV + pos) * HD + cl) = w; } }
            return;
        }
        const bool isk = (u.pn == 4);
#pragma unroll
        for (int ai = 0; ai < 2; ++ai)
#pragma unroll
            for (int m = 0; m < 4; ++m)
#pragma unroll
                for (int bj = 0; bj < 2; ++bj) { const f32x4 v0 = acc[ai][bj][m][0], v1 = acc[ai][bj][m][1];
                    float s = (v0[0] * v0[0] + v0[1] * v0[1]) + (v0[2] * v0[2] + v0[3] * v0[3]) + (v1[0] * v1[0] + v1[1] * v1[1]) + (v1[2] * v1[2] + v1[3] * v1[3]);
                    s += __shfl_xor(s, 16); s += __shfl_xor(s, 32);
                    if (fq == 0) xs[((ai * HALF + rl0 + m * 16) * 2 + bj) * 4 + wc] = s; }
        asm volatile("s_waitcnt lgkmcnt(0)" ::: "memory"); __builtin_amdgcn_s_barrier(); asm volatile("" ::: "memory");
        const float* g = isk ? gk : gq;
        const int p0 = 16 * wc + 4 * fq;
        const f32x4 ga = *(const f32x4*)(g + p0), gb = *(const f32x4*)(g + 64 + p0);
#pragma unroll
        for (int ai = 0; ai < 2; ++ai)
#pragma unroll
            for (int m = 0; m < 4; ++m) { const int rl = ai * HALF + rl0 + m * 16, R = u.pm * BM + rl; int b, pos; bool isctx = false;
                if (R < MTOK) { b = R >> 12; pos = R & 4095; } else { const int r2 = R - MTOK; b = r2 >> 8; pos = SEQ + (r2 & 255); isctx = true; }
                f32x4 t0 = (f32x4){1.f, 0.f, 1.f, 0.f}, t1 = (f32x4){1.f, 0.f, 1.f, 0.f};
                if (!isctx) { const int pp = (wc < 2) ? (pos >> 6) : (pos & 63); const float* tp = rope + ((size_t)pp * 32 + (p0 & 31)) * 2;
                    t0 = *(const f32x4*)tp; t1 = *(const f32x4*)(tp + 4); }
#pragma unroll
                for (int bj = 0; bj < 2; ++bj) {
                    const f32x4 part = *(const LAS f32x4*)(xs + (rl * 2 + bj) * 4);
                    const float rstd = __builtin_amdgcn_rsqf(((part[0] + part[1]) + (part[2] + part[3])) * (1.0f / 128.0f) + EPSN);
                    const f32x4 v0 = acc[ai][bj][m][0], v1 = acc[ai][bj][m][1];
                    const float a0 = v0[0] * rstd * ga[0], b0 = v0[1] * rstd * gb[0], a1 = v0[2] * rstd * ga[1], b1 = v0[3] * rstd * gb[1];
                    const float a2 = v1[0] * rstd * ga[2], b2 = v1[1] * rstd * gb[2], a3 = v1[2] * rstd * ga[3], b3 = v1[3] * rstd * gb[3];
                    u32x4 w;
                    w.x = cvtpk(a0 * t0[0] - b0 * t0[1], a0 * t0[1] + b0 * t0[0]); w.y = cvtpk(a1 * t0[2] - b1 * t0[3], a1 * t0[3] + b1 * t0[2]);
                    w.z = cvtpk(a2 * t1[0] - b2 * t1[1], a2 * t1[1] + b2 * t1[0]); w.w = cvtpk(a3 * t1[2] - b3 * t1[3], a3 * t1[3] + b3 * t1[2]);
                    bf16_t* dst = isk ? (Kc + ((size_t)(b * NKVH + bj) * SKV + pos) * HD + cl) : (Q + (size_t)R * DM + (2 * u.pn + bj) * HD + cl);
                    *(u32x4*)dst = w; }
                __builtin_amdgcn_sched_barrier(0); }
    }
};

template <class Sched> __device__ __forceinline__ void rstd_prestep(const Sched& S, const float* __restrict__ ssq, const float* __restrict__ shw, LAS float* xs) {
    const int t = threadIdx.x, rowl = t >> 1, half = t & 1;
#pragma unroll 1
    for (int i = 0; i < 12; ++i) { Unit u; if (!S.next(i, u)) break;
        const float* pp = ssq + (size_t)(u.pm * BM + rowl) * 16 + half * 8;
        const f32x4 a = *(const f32x4*)pp, c = *(const f32x4*)(pp + 4); float s = ((a[0] + a[1]) + (a[2] + a[3])) + ((c[0] + c[1]) + (c[2] + c[3]));
        s += __shfl_xor(s, 1);
        if (half == 0) xs[i * 256 + rowl] = __builtin_amdgcn_rsqf(s * (1.0f / DM) + EPSN);
        if (t < 256) xs[3072 + i * 256 + t] = shw[(size_t)((u.pm * BM) >> 12) * (2 * DFF) + u.pn * BM + t]; }
    __syncthreads();
}
constexpr int NW = 8, QBLK = 32, KVBLK = 64;
constexpr float SCALE = 0.088388347648318440f, THR = 8.f;
constexpr int LDQ = DM, LDK = HD, LDO = DM;
constexpr size_t SHM_V = KVBLK * HD * 2, SHM_K = KVBLK * HD * 2, SHM_ATTN = 2 * SHM_V + 2 * SHM_K + NW * 64 * 4;
#define KSWZ(row, colB) ((row) * 256 + ((colB) ^ (((row) & 7) << 4)))
#define SBAR() __builtin_amdgcn_sched_barrier(0)
__device__ __forceinline__ int crow(int r, int hi) { return (r & 3) + 8 * (r >> 2) + 4 * hi; }
__device__ __forceinline__ void partialSM(f32x16& p0, f32x16& p1, float mnC) {
  constexpr float C = SCALE * 1.4426950408889634f;
  for (int r = 0; r < 16; ++r) p0[r] = fmaf(p0[r], C, mnC); for (int r = 0; r < 16; ++r) p1[r] = fmaf(p1[r], C, mnC);
  for (int r = 0; r < 16; ++r) p0[r] = __builtin_amdgcn_exp2f(p0[r]);
}
__device__ __forceinline__ void finishSM(f32x16& p0, f32x16& p1, float& l_reg, bf16x8& pa0, bf16x8& pa1, bf16x8& pa2, bf16x8& pa3) {
  for (int r = 0; r < 16; ++r) p1[r] = __builtin_amdgcn_exp2f(p1[r]);
  float ps = 0; for (int r = 0; r < 16; ++r) ps += p0[r]; for (int r = 0; r < 16; ++r) ps += p1[r];
  { auto rr = __builtin_amdgcn_permlane32_swap(__float_as_uint(ps), __float_as_uint(ps), false, false);
    ps = __uint_as_float(rr[0]) + __uint_as_float(rr[1]); }
  l_reg += ps;
#define PK4(P, BASE, OUT) do { unsigned a0 = cvtpk(P[BASE + 0], P[BASE + 1]), a1 = cvtpk(P[BASE + 2], P[BASE + 3]);   \
    unsigned b0 = cvtpk(P[BASE + 4], P[BASE + 5]), b1 = cvtpk(P[BASE + 6], P[BASE + 7]);                              \
    auto r0 = __builtin_amdgcn_permlane32_swap(a0, b0, false, false); auto r1 = __builtin_amdgcn_permlane32_swap(a1, b1, false, false); \
    u32x4 w = {r0[0], r1[0], r0[1], r1[1]}; OUT = *reinterpret_cast<bf16x8*>(&w); } while (0)
  PK4(p0, 0, pa0); PK4(p0, 8, pa1); PK4(p1, 0, pa2); PK4(p1, 8, pa3);
#undef PK4
}
__device__ __forceinline__ void qkt(f32x16& p0, f32x16& p1, const bf16_t* Ks, const bf16x8* qr, int r32, int hi) {
  p0 = f32x16{}; p1 = f32x16{};
  const char* kp = (const char*)Ks;
#pragma unroll
  for (int h = 0; h < 2; ++h) {
    bf16x8 b0[4], b1[4];
#pragma unroll
    for (int q = 0; q < 4; ++q) { const int cb = ((h * 4 + q) * 16 + hi * 8) * 2;
      b0[q] = *reinterpret_cast<const bf16x8*>(kp + KSWZ(r32, cb)); b1[q] = *reinterpret_cast<const bf16x8*>(kp + KSWZ(32 + r32, cb)); }
    __builtin_amdgcn_sched_barrier(0x6);
#pragma unroll
    for (int q = 0; q < 4; ++q) {
      p0 = __builtin_amdgcn_mfma_f32_32x32x16_bf16(b0[q], qr[h * 4 + q], p0, 0, 0, 0);
      p1 = __builtin_amdgcn_mfma_f32_32x32x16_bf16(b1[q], qr[h * 4 + q], p1, 0, 0, 0); }
    __builtin_amdgcn_sched_barrier(0x6);
  }
}
__device__ __forceinline__ int v_st(int k, int c) { const int kk = (k & ~0xC) | ((k & 4) << 1) | ((k & 8) >> 1); return ((kk >> 3) * 4 + (c >> 5)) * 512 + ((kk & 7) * 32 + (c & 31)) * 2; }
__device__ __forceinline__ int v_rd_base(int lane) { return ((lane & 3) << 3) | (((lane >> 2) & 3) << 6) | (((lane >> 4) & 1) << 5) | (((lane >> 5) & 1) << 8); }
constexpr int v_rd_off(int d0, int ks, int half) { return d0 * 512 + ks * 4096 + half * 2048; }
template <int OFF> __device__ __forceinline__ s16x4 tr_read(int vb) {
  s16x4 r; asm volatile("ds_read_b64_tr_b16 %0, %1 offset:%2" : "=&v"(r) : "v"(vb), "i"(OFF) : "memory"); return r;
}
template <int D0> __device__ __forceinline__ void pv_one(f32x16& od, int vb, bf16x8 pa0, bf16x8 pa1, bf16x8 pa2, bf16x8 pa3) {
  const s16x4 l0 = tr_read<v_rd_off(D0, 0, 0)>(vb), h0 = tr_read<v_rd_off(D0, 0, 1)>(vb), l1 = tr_read<v_rd_off(D0, 1, 0)>(vb), h1 = tr_read<v_rd_off(D0, 1, 1)>(vb);
  const s16x4 l2 = tr_read<v_rd_off(D0, 2, 0)>(vb), h2 = tr_read<v_rd_off(D0, 2, 1)>(vb), l3 = tr_read<v_rd_off(D0, 3, 0)>(vb), h3 = tr_read<v_rd_off(D0, 3, 1)>(vb);
  asm volatile("s_waitcnt lgkmcnt(0)" ::: "memory"); SBAR();
#define PK(L, H) (bf16x8){L[0], L[1], L[2], L[3], H[0], H[1], H[2], H[3]}
  od = __builtin_amdgcn_mfma_f32_32x32x16_bf16(pa0, PK(l0, h0), od, 0, 0, 0);
  od = __builtin_amdgcn_mfma_f32_32x32x16_bf16(pa1, PK(l1, h1), od, 0, 0, 0);
  od = __builtin_amdgcn_mfma_f32_32x32x16_bf16(pa2, PK(l2, h2), od, 0, 0, 0);
  od = __builtin_amdgcn_mfma_f32_32x32x16_bf16(pa3, PK(l3, h3), od, 0, 0, 0);
#undef PK
}
__device__ __forceinline__ void pv_d0(f32x16* o, int vb, bf16x8 pa0, bf16x8 pa1, bf16x8 pa2, bf16x8 pa3) {
  pv_one<0>(o[0], vb, pa0, pa1, pa2, pa3); pv_one<1>(o[1], vb, pa0, pa1, pa2, pa3); pv_one<2>(o[2], vb, pa0, pa1, pa2, pa3); pv_one<3>(o[3], vb, pa0, pa1, pa2, pa3);
}
__device__ __forceinline__ void attn_dense_body(const bf16_t* __restrict__ Qb, const bf16_t* __restrict__ Kh, const bf16_t* __restrict__ Vh,
                                                bf16_t* __restrict__ Ob, int seq, char* lds, LAS unsigned char* ldsl, float mnC) {
  const int tid = threadIdx.x, wid = __builtin_amdgcn_readfirstlane(tid >> 6), lane = tid & 63, r32 = lane & 31, hi = lane >> 5;
  constexpr int SLOT = 32768;
  float* ws = (float*)(lds + 3 * SLOT) + wid * 64; float* li_l = ws;
  float l_reg = 0; f32x16 o[4] = {}; bf16x8 qr[8];
  unsigned voffK[2], voffV[2];
#pragma unroll
  for (int i = 0; i < 2; ++i) { const int P16 = i * 512 + tid;
    { const int row = P16 >> 4, g = (P16 & 15) ^ (row & 7); voffK[i] = (unsigned)(row * LDK + g * 8) * 2u; }
    { const int sub = P16 >> 5, kk = (sub >> 2) * 8 + ((P16 >> 2) & 7), c = (sub & 3) * 32 + (P16 & 3) * 8, k = (kk & ~0xC) | ((kk & 4) << 1) | ((kk & 8) >> 1);
      voffV[i] = (unsigned)(k * LDK + c) * 2u; } }
#define ADMA(jt, b) do { const char* _gk = (const char*)Kh + (size_t)(jt) * (KVBLK * LDK * 2); const char* _gv = (const char*)Vh + (size_t)(jt) * (KVBLK * LDK * 2); \
    _Pragma("unroll") for (int _i = 0; _i < 2; ++_i) { \
      __builtin_amdgcn_global_load_lds((const unsigned*)(_gv + voffV[_i]), (LAS unsigned*)(ldsl + (b) * SLOT + wid * 1024 + _i * 8192), 16, 0, 0); \
      __builtin_amdgcn_global_load_lds((const unsigned*)(_gk + voffK[_i]), (LAS unsigned*)(ldsl + (b) * SLOT + 16384 + wid * 1024 + _i * 8192), 16, 0, 0); } } while (0)
#define KBUF(b) ((const bf16_t*)(lds + (b) * SLOT + 16384))
  const int NT = seq / KVBLK;
  ADMA(0, 0); ADMA(1, 1);
  const bf16_t* Qw = Qb + (long)(wid * QBLK + r32) * LDQ + hi * 8;
#pragma unroll
  for (int d0 = 0; d0 < 8; ++d0) qr[d0] = *reinterpret_cast<const bf16x8*>(Qw + d0 * 16);
  const int vb0 = (int)(uintptr_t)lds + v_rd_base(lane);
  f32x16 pA0, pA1, pB0, pB1; bf16x8 pa0, pa1, pa2, pa3;
  asm volatile("s_waitcnt vmcnt(0)" ::: "memory"); __syncthreads();
  qkt(pA0, pA1, KBUF(0), qr, r32, hi); partialSM(pA0, pA1, mnC);
  int bv = 0, bk = 1, bn = 2;
  for (int j = 1; j + 1 < NT; j += 2) {
    ADMA(j + 1, bn);
    SBAR(); qkt(pB0, pB1, KBUF(bk), qr, r32, hi);
    finishSM(pA0, pA1, l_reg, pa0, pa1, pa2, pa3); SBAR();
    pv_d0(o, vb0 + bv * SLOT, pa0, pa1, pa2, pa3); partialSM(pB0, pB1, mnC);
    asm volatile("s_waitcnt vmcnt(0)" ::: "memory"); __syncthreads();
    { const int t_ = bv; bv = bk; bk = bn; bn = t_; }
    if (j + 2 < NT) ADMA(j + 2, bn);
    SBAR(); qkt(pA0, pA1, KBUF(bk), qr, r32, hi);
    finishSM(pB0, pB1, l_reg, pa0, pa1, pa2, pa3); SBAR();
    pv_d0(o, vb0 + bv * SLOT, pa0, pa1, pa2, pa3); partialSM(pA0, pA1, mnC);
    asm volatile("s_waitcnt vmcnt(0)" ::: "memory"); __syncthreads();
    { const int t_ = bv; bv = bk; bk = bn; bn = t_; }
  }
  SBAR(); qkt(pB0, pB1, KBUF(bk), qr, r32, hi);
  finishSM(pA0, pA1, l_reg, pa0, pa1, pa2, pa3); SBAR();
  pv_d0(o, vb0 + bv * SLOT, pa0, pa1, pa2, pa3); partialSM(pB0, pB1, mnC);
  finishSM(pB0, pB1, l_reg, pa0, pa1, pa2, pa3); SBAR();
  pv_d0(o, vb0 + bk * SLOT, pa0, pa1, pa2, pa3);
  if (hi == 0) li_l[r32] = l_reg; asm volatile("s_waitcnt lgkmcnt(0)" ::: "memory");
  float rli[16];
#pragma unroll
  for (int r = 0; r < 16; ++r) rli[r] = __builtin_amdgcn_rcpf(li_l[crow(r, hi)]);
  bf16_t* Ow = Ob + (long)(wid * QBLK) * LDO;
#pragma unroll
  for (int r = 0; r < 16; ++r) { int orow = crow(r, hi);
    for (int d0 = 0; d0 < 4; ++d0) Ow[(long)orow * LDO + d0 * 32 + r32] = (bf16_t)(cvtpk(o[d0][r] * rli[r], 0.f) & 0xffffu); }
#undef ADMA
#undef KBUF
}

__device__ __forceinline__ void phase_fft1(const bf16_t* __restrict__ Xb, const float* __restrict__ ssq, const float* __restrict__ gmix, const float* __restrict__ modl,
                                           bf16_t* __restrict__ AP, char* lds) {
    const int tid = threadIdx.x, wid = tid >> 6, lane = tid & 63, r32 = lane & 31, hi = lane >> 5, kb = wid & 3, dh = wid >> 2, G = gridDim.x;
    float* tab = (float*)(lds + 65536);
    float* rs = (float*)(lds + 81920);
    for (int i = tid; i < 4096; i += 512) tab[i] = __builtin_amdgcn_cosf((float)i * (1.0f / 4096.0f));
    for (int idx = tid; idx < 1024; idx += 512) { const int i = idx >> 6, n1 = idx & 63, t = blockIdx.x + G * i;
        if (t < 4096) { const float* pp = ssq + (size_t)((t >> 9) * SEQ + 64 * n1 + ((t >> 3) & 63)) * 16;
            const f32x4 a = *(const f32x4*)pp, b = *(const f32x4*)(pp + 4), c = *(const f32x4*)(pp + 8), d = *(const f32x4*)(pp + 12);
            const float s = (((a[0] + a[1]) + (a[2] + a[3])) + ((b[0] + b[1]) + (b[2] + b[3]))) + (((c[0] + c[1]) + (c[2] + c[3])) + ((d[0] + d[1]) + (d[2] + d[3])));
            rs[idx] = __builtin_amdgcn_rsqf(s * (1.0f / DM) + EPSN); } }
    __syncthreads();
    bf16x8 pa[4];
    { const int k1 = 16 * kb + (r32 & 15), isim = r32 >> 4;
#pragma unroll
      for (int j = 0; j < 4; ++j) { u32x4 w; unsigned ww[4];
#pragma unroll
        for (int e2 = 0; e2 < 4; ++e2) { float v[2];
#pragma unroll
          for (int q = 0; q < 2; ++q) { const int n1 = 16 * j + 8 * hi + 2 * e2 + q, m = ((k1 * n1) & 63) * 64; v[q] = tab[isim ? ((m + 1024) & 4095) : m] * 0.125f; }
          ww[e2] = cvtpk(v[0], v[1]); }
        w.x = ww[0]; w.y = ww[1]; w.z = ww[2]; w.w = ww[3]; pa[j] = *reinterpret_cast<bf16x8*>(&w); } }
    const int sr = tid >> 4, sc = (tid & 15) * 8, vst0 = v_st(sr, sc), vst1 = v_st(32 + sr, sc);
    const int vb0 = (int)(uintptr_t)lds + v_rd_base(lane) + dh * 1024;
    u32x4 s0, s1; f32x4 pg0, pg1, psh0, psh1, psc0, psc1;
#define F1_SRC(t, n1) (Xb + ((size_t)(((t) >> 9) * SEQ + 64 * (n1) + (((t) >> 3) & 63))) * DM + ((t) & 7) * 128 + sc)
#define F1_LOAD(t) do { s0 = *reinterpret_cast<const u32x4*>(F1_SRC(t, sr)); s1 = *reinterpret_cast<const u32x4*>(F1_SRC(t, 32 + sr)); \
        const int ch0 = ((t) & 7) * 128 + sc; const float* mp = modl + (size_t)((t) >> 9) * 6144 + ch0; \
        pg0 = *(const f32x4*)(gmix + ch0); pg1 = *(const f32x4*)(gmix + ch0 + 4); psh0 = *(const f32x4*)mp; psh1 = *(const f32x4*)(mp + 4); \
        psc0 = *(const f32x4*)(mp + 1024) + 1.0f; psc1 = *(const f32x4*)(mp + 1028) + 1.0f; } while (0)
#define F1_NORM(S, R) ({ const f32x4 x0 = (f32x4){__uint_as_float(S[0] << 16), __uint_as_float(S[0] & 0xffff0000u), __uint_as_float(S[1] << 16), __uint_as_float(S[1] & 0xffff0000u)}; \
        const f32x4 x1 = (f32x4){__uint_as_float(S[2] << 16), __uint_as_float(S[2] & 0xffff0000u), __uint_as_float(S[3] << 16), __uint_as_float(S[3] & 0xffff0000u)}; \
        const f32x4 y0 = (x0 * (R) * pg0) * psc0 + psh0, y1 = (x1 * (R) * pg1) * psc1 + psh1; \
        u32x4 w; w.x = cvtpk(y0[0], y0[1]); w.y = cvtpk(y0[2], y0[3]); w.z = cvtpk(y1[0], y1[1]); w.w = cvtpk(y1[2], y1[3]); w; })
    int t = blockIdx.x, buf = 0, it = 0;
    if (t < 4096) F1_LOAD(t);
    for (; t < 4096; t += G, ++it) {
        { const float r0 = rs[it * 64 + sr], r1 = rs[it * 64 + 32 + sr];
          const u32x4 w0 = F1_NORM(s0, r0), w1 = F1_NORM(s1, r1);
          *(u32x4*)(lds + buf * 16384 + vst0) = w0; *(u32x4*)(lds + buf * 16384 + vst1) = w1; }
        __syncthreads();
        const int tn = t + G;
        if (tn < 4096) F1_LOAD(tn);
        if (kb < 3) {
        f32x16 o0 = {}, o1 = {};
        const int vb = vb0 + buf * 16384;
        pv_one<0>(o0, vb, pa[0], pa[1], pa[2], pa[3]); pv_one<1>(o1, vb, pa[0], pa[1], pa[2], pa[3]);
        const int b = t >> 9, n2 = (t >> 3) & 63, chblk = t & 7;
#pragma unroll
        for (int r = 0; r < 8; ++r) { const int k1 = 16 * kb + crow(r, hi), m = (k1 * n2) & 4095; const float cw = tab[m], sw = tab[(m + 1024) & 4095];
            bf16_t* dst = AP + ((((size_t)b * 64 + k1) * 2) * 64 + n2) * DM + chblk * 128 + dh * 64 + r32;
            const float re0 = o0[r], im0 = o0[r + 8], re1 = o1[r], im1 = o1[r + 8];
            if (k1 <= 32) {
            dst[0] = (bf16_t)(cvtpk(re0 * cw - im0 * sw, 0.f) & 0xffffu); dst[32] = (bf16_t)(cvtpk(re1 * cw - im1 * sw, 0.f) & 0xffffu);
            dst[65536] = (bf16_t)(cvtpk(re0 * sw + im0 * cw, 0.f) & 0xffffu); dst[65536 + 32] = (bf16_t)(cvtpk(re1 * sw + im1 * cw, 0.f) & 0xffffu); } }
        }
        buf ^= 1;
    }
#undef F1_SRC
#undef F1_LOAD
#undef F1_NORM
    __syncthreads();
}
__device__ __forceinline__ void phase_fft3(const bf16_t* __restrict__ AP, bf16_t* __restrict__ Z, char* lds) {
    const int tid = threadIdx.x, wid = tid >> 6, lane = tid & 63, r32 = lane & 31, hi = lane >> 5, kb = wid & 3, dh = wid >> 2, G = gridDim.x;
    float* tab = (float*)(lds + 65536);
    for (int i = tid; i < 4096; i += 512) tab[i] = __builtin_amdgcn_cosf((float)i * (1.0f / 4096.0f));
    __syncthreads();
    bf16x8 pa[8];
    { const int k2 = 16 * kb + (r32 & 15), ri = r32 >> 4;
#pragma unroll
      for (int j = 0; j < 8; ++j) { u32x4 w; unsigned ww[4];
#pragma unroll
        for (int e2 = 0; e2 < 4; ++e2) { float v[2];
#pragma unroll
          for (int q = 0; q < 2; ++q) { const int kap = 16 * j + 8 * hi + 2 * e2 + q, rip = kap >> 6, n2 = kap & 63, m = ((k2 * n2) & 63) * 64;
              const int id = (ri == rip) ? m : (ri == 0 ? ((m - 1024) & 4095) : ((m + 1024) & 4095));
              v[q] = tab[id] * 0.125f; }
          ww[e2] = cvtpk(v[0], v[1]); }
        w.x = ww[0]; w.y = ww[1]; w.z = ww[2]; w.w = ww[3]; pa[j] = *reinterpret_cast<bf16x8*>(&w); } }
    const int sr = tid >> 4, sc = (tid & 15) * 8, vst0 = v_st(sr, sc), vst1 = v_st(32 + sr, sc);
    const int vb0 = (int)(uintptr_t)lds + v_rd_base(lane) + dh * 1024;
    bf16x8 s0, s1, s2, s3;
    constexpr int NT3 = NBATCH * 33 * 8;
#define T3_IDX(tp) ((((tp) >> 3) / 33) * 64 + (((tp) >> 3) % 33))
#define F3_SRC(tp, rip, n2) (AP + (((size_t)T3_IDX(tp) * 2 + (rip)) * 64 + (n2)) * DM + ((tp) & 7) * 128 + sc)
    int t = blockIdx.x, buf = 0;
    if (t < NT3) { s0 = *reinterpret_cast<const bf16x8*>(F3_SRC(t, 0, sr)); s1 = *reinterpret_cast<const bf16x8*>(F3_SRC(t, 0, 32 + sr));
                   s2 = *reinterpret_cast<const bf16x8*>(F3_SRC(t, 1, sr)); s3 = *reinterpret_cast<const bf16x8*>(F3_SRC(t, 1, 32 + sr)); }
    for (; t < NT3; t += G) {
        char* lb = lds + buf * 32768;
        *(bf16x8*)(lb + vst0) = s0; *(bf16x8*)(lb + vst1) = s1; *(bf16x8*)(lb + 16384 + vst0) = s2; *(bf16x8*)(lb + 16384 + vst1) = s3;
        __syncthreads();
        const int tn = t + G;
        if (tn < NT3) { s0 = *reinterpret_cast<const bf16x8*>(F3_SRC(tn, 0, sr)); s1 = *reinterpret_cast<const bf16x8*>(F3_SRC(tn, 0, 32 + sr));
                        s2 = *reinterpret_cast<const bf16x8*>(F3_SRC(tn, 1, sr)); s3 = *reinterpret_cast<const bf16x8*>(F3_SRC(tn, 1, 32 + sr)); }
        f32x16 o0 = {}, o1 = {};
        const int vb = vb0 + buf * 32768;
        pv_one<0>(o0, vb, pa[0], pa[1], pa[2], pa[3]); pv_one<1>(o1, vb, pa[0], pa[1], pa[2], pa[3]);
        pv_one<0>(o0, vb + 16384, pa[4], pa[5], pa[6], pa[7]); pv_one<1>(o1, vb + 16384, pa[4], pa[5], pa[6], pa[7]);
        const int idx = T3_IDX(t), b = idx >> 6, k1 = idx & 63, ch = (t & 7) * 128 + dh * 64 + r32, g = ch >> 8, cw = ch & 255;
        const bool mir = (k1 >= 1) && (k1 <= 31);
#pragma unroll
        for (int r = 0; r < 8; ++r) { const int k2 = 16 * kb + crow(r, hi);
            const unsigned re0 = cvtpk(o0[r], 0.f) & 0xffffu, re1 = cvtpk(o1[r], 0.f) & 0xffffu;
            bf16_t* dst = Z + ((size_t)(b * SEQ + k1 + 64 * k2)) * 2048 + g * 512 + cw;
            dst[0] = (bf16_t)re0; dst[32] = (bf16_t)re1;
            dst[256] = (bf16_t)(cvtpk(o0[r + 8], 0.f) & 0xffffu); dst[256 + 32] = (bf16_t)(cvtpk(o1[r + 8], 0.f) & 0xffffu);
            if (mir) { bf16_t* dm = Z + ((size_t)(b * SEQ + (64 - k1) + 64 * (63 - k2))) * 2048 + g * 512 + cw;
                dm[0] = (bf16_t)re0; dm[32] = (bf16_t)re1;
                dm[256] = (bf16_t)(cvtpk(-o0[r + 8], 0.f) & 0xffffu); dm[256 + 32] = (bf16_t)(cvtpk(-o1[r + 8], 0.f) & 0xffffu); } }
        buf ^= 1;
    }
#undef T3_IDX
#undef F3_SRC
    __syncthreads();
}

__device__ __forceinline__ float wave_sum(float s) {
    s += __shfl_xor(s, 1); s += __shfl_xor(s, 2); s += __shfl_xor(s, 4); s += __shfl_xor(s, 8); s += __shfl_xor(s, 16); s += __shfl_xor(s, 32); return s;
}
__device__ __forceinline__ void normmod_rows(const float* __restrict__ src, bf16_t* __restrict__ dst, const float* __restrict__ g, const float* __restrict__ modl,
                                             int jshift, int nrows, int bshift, int brow0) {
    const int lane = threadIdx.x & 63, gw = blockIdx.x * 8 + (threadIdx.x >> 6), nw = gridDim.x * 8;
    f32x4 gv[4];
#pragma unroll
    for (int i = 0; i < 4; ++i) gv[i] = *(const f32x4*)(g + lane * 4 + 256 * i);
    for (int row = gw; row < nrows; row += 2 * nw) {
        const int row2 = row + nw; const bool has2 = row2 < nrows;
        const float* x0 = src + (size_t)row * DM + lane * 4; const float* x1 = src + (size_t)(has2 ? row2 : row) * DM + lane * 4;
        f32x4 v0[4], v1[4];
#pragma unroll
        for (int i = 0; i < 4; ++i) { v0[i] = *(const f32x4*)(x0 + 256 * i); v1[i] = *(const f32x4*)(x1 + 256 * i); }
        float s0 = 0.f, s1 = 0.f;
#pragma unroll
        for (int i = 0; i < 4; ++i) { s0 += (v0[i][0] * v0[i][0] + v0[i][1] * v0[i][1]) + (v0[i][2] * v0[i][2] + v0[i][3] * v0[i][3]);
                                      s1 += (v1[i][0] * v1[i][0] + v1[i][1] * v1[i][1]) + (v1[i][2] * v1[i][2] + v1[i][3] * v1[i][3]); }
        s0 = wave_sum(s0); s1 = wave_sum(s1);
        const float r0 = __builtin_amdgcn_rsqf(s0 * (1.0f / DM) + EPSN), r1 = __builtin_amdgcn_rsqf(s1 * (1.0f / DM) + EPSN);
        const float* m0 = modl + (size_t)(brow0 + (row >> bshift)) * 6144 + jshift * 1024 + lane * 4;
        const float* m1 = modl + (size_t)(brow0 + ((has2 ? row2 : row) >> bshift)) * 6144 + jshift * 1024 + lane * 4;
#pragma unroll
        for (int i = 0; i < 4; ++i) {
            const f32x4 sh0 = *(const f32x4*)(m0 + 256 * i), sc0 = *(const f32x4*)(m0 + 1024 + 256 * i);
            const f32x4 y0 = (v0[i] * r0 * gv[i]) * (sc0 + 1.0f) + sh0;
            u32x2 w0; w0.x = cvtpk(y0[0], y0[1]); w0.y = cvtpk(y0[2], y0[3]);
            *(u32x2*)(dst + (size_t)row * DM + lane * 4 + 256 * i) = w0;
            if (has2) { const f32x4 sh1 = *(const f32x4*)(m1 + 256 * i), sc1 = *(const f32x4*)(m1 + 1024 + 256 * i);
                const f32x4 y1 = (v1[i] * r1 * gv[i]) * (sc1 + 1.0f) + sh1;
                u32x2 w1; w1.x = cvtpk(y1[0], y1[1]); w1.y = cvtpk(y1[2], y1[3]);
                *(u32x2*)(dst + (size_t)row2 * DM + lane * 4 + 256 * i) = w1; }
        }
    }
}
__device__ __forceinline__ void final_norm(const float* __restrict__ src, float* __restrict__ dst, const float* __restrict__ g) {
    const int lane = threadIdx.x & 63, gw = blockIdx.x * 8 + (threadIdx.x >> 6), nw = gridDim.x * 8;
    f32x4 gv[4];
#pragma unroll
    for (int i = 0; i < 4; ++i) gv[i] = *(const f32x4*)(g + lane * 4 + 256 * i);
    for (int row = gw; row < MTOK; row += 2 * nw) {
        const int row2 = row + nw; const bool has2 = row2 < MTOK;
        const float* x0 = src + (size_t)row * DM + lane * 4; const float* x1 = src + (size_t)(has2 ? row2 : row) * DM + lane * 4;
        f32x4 v0[4], v1[4];
#pragma unroll
        for (int i = 0; i < 4; ++i) { v0[i] = *(const f32x4*)(x0 + 256 * i); v1[i] = *(const f32x4*)(x1 + 256 * i); }
        float s0 = 0.f, s1 = 0.f;
#pragma unroll
        for (int i = 0; i < 4; ++i) { s0 += (v0[i][0] * v0[i][0] + v0[i][1] * v0[i][1]) + (v0[i][2] * v0[i][2] + v0[i][3] * v0[i][3]);
                                      s1 += (v1[i][0] * v1[i][0] + v1[i][1] * v1[i][1]) + (v1[i][2] * v1[i][2] + v1[i][3] * v1[i][3]); }
        s0 = wave_sum(s0); s1 = wave_sum(s1);
        const float r0 = __builtin_amdgcn_rsqf(s0 * (1.0f / DM) + EPSN), r1 = __builtin_amdgcn_rsqf(s1 * (1.0f / DM) + EPSN);
#pragma unroll
        for (int i = 0; i < 4; ++i) { *(f32x4*)(dst + (size_t)row * DM + lane * 4 + 256 * i) = v0[i] * r0 * gv[i];
            if (has2) *(f32x4*)(dst + (size_t)row2 * DM + lane * 4 + 256 * i) = v1[i] * r1 * gv[i]; }
    }
}

__device__ __forceinline__ void normmod_rows_b(const bf16_t* __restrict__ src, bf16_t* __restrict__ dst, const float* __restrict__ g, const float* __restrict__ modl, int jshift, int nrows) {
    const int lane = threadIdx.x & 63, gw = blockIdx.x * 8 + (threadIdx.x >> 6), nw = gridDim.x * 8;
    f32x4 gv[4];
    gv[0] = *(const f32x4*)(g + lane * 8); gv[1] = *(const f32x4*)(g + lane * 8 + 4); gv[2] = *(const f32x4*)(g + 512 + lane * 8); gv[3] = *(const f32x4*)(g + 512 + lane * 8 + 4);
    for (int row = gw; row < nrows; row += nw) {
        const u32x4 a0 = *(const u32x4*)(src + (size_t)row * DM + lane * 8), a1 = *(const u32x4*)(src + (size_t)row * DM + 512 + lane * 8);
        f32x4 v[4];
        v[0] = (f32x4){__uint_as_float(a0[0] << 16), __uint_as_float(a0[0] & 0xffff0000u), __uint_as_float(a0[1] << 16), __uint_as_float(a0[1] & 0xffff0000u)};
        v[1] = (f32x4){__uint_as_float(a0[2] << 16), __uint_as_float(a0[2] & 0xffff0000u), __uint_as_float(a0[3] << 16), __uint_as_float(a0[3] & 0xffff0000u)};
        v[2] = (f32x4){__uint_as_float(a1[0] << 16), __uint_as_float(a1[0] & 0xffff0000u), __uint_as_float(a1[1] << 16), __uint_as_float(a1[1] & 0xffff0000u)};
        v[3] = (f32x4){__uint_as_float(a1[2] << 16), __uint_as_float(a1[2] & 0xffff0000u), __uint_as_float(a1[3] << 16), __uint_as_float(a1[3] & 0xffff0000u)};
        float s = 0.f;
#pragma unroll
        for (int i = 0; i < 4; ++i) s += (v[i][0] * v[i][0] + v[i][1] * v[i][1]) + (v[i][2] * v[i][2] + v[i][3] * v[i][3]);
        s = wave_sum(s);
        const float r = __builtin_amdgcn_rsqf(s * (1.0f / DM) + EPSN);
        const float* m0 = modl + (size_t)(row >> 12) * 6144 + jshift * 1024;
        u32x4 w[2];
#pragma unroll
        for (int i = 0; i < 4; ++i) { const int c = (i >> 1) * 512 + lane * 8 + (i & 1) * 4;
            const f32x4 sh = *(const f32x4*)(m0 + c), sc = *(const f32x4*)(m0 + 1024 + c);
            const f32x4 y = (v[i] * r * gv[i]) * (sc + 1.0f) + sh;
            w[i >> 1][(i & 1) * 2] = cvtpk(y[0], y[1]); w[i >> 1][(i & 1) * 2 + 1] = cvtpk(y[2], y[3]); }
        *(u32x4*)(dst + (size_t)row * DM + lane * 8) = w[0]; *(u32x4*)(dst + (size_t)row * DM + 512 + lane * 8) = w[1];
    }
}
__device__ __forceinline__ void final_norm_bf16(const bf16_t* __restrict__ xb, const float* __restrict__ ssq, float* __restrict__ dst, const float* __restrict__ g) {
    const int lane = threadIdx.x & 63, gw = blockIdx.x * 8 + (threadIdx.x >> 6), nw = gridDim.x * 8;
    f32x4 gv[4];
    gv[0] = *(const f32x4*)(g + lane * 8); gv[1] = *(const f32x4*)(g + lane * 8 + 4); gv[2] = *(const f32x4*)(g + 512 + lane * 8); gv[3] = *(const f32x4*)(g + 512 + lane * 8 + 4);
    for (int row = gw; row < MTOK; row += 2 * nw) {
        const int row2 = (row + nw < MTOK) ? row + nw : row;
        const u32x4 a0 = *(const u32x4*)(xb + (size_t)row * DM + lane * 8), a1 = *(const u32x4*)(xb + (size_t)row * DM + 512 + lane * 8);
        const u32x4 b0 = *(const u32x4*)(xb + (size_t)row2 * DM + lane * 8), b1 = *(const u32x4*)(xb + (size_t)row2 * DM + 512 + lane * 8);
        float s0 = (lane < 16) ? ssq[(size_t)row * 16 + lane] : 0.f, s1 = (lane < 16) ? ssq[(size_t)row2 * 16 + lane] : 0.f;
        s0 = wave_sum(s0); s1 = wave_sum(s1);
        const float r0 = __builtin_amdgcn_rsqf(s0 * (1.0f / DM) + EPSN), r1 = __builtin_amdgcn_rsqf(s1 * (1.0f / DM) + EPSN);
#define FN_OUT(A, R, ROW, OFF, G0, G1) do { f32x4 y0, y1; \
        y0[0] = __uint_as_float(A[0] << 16); y0[1] = __uint_as_float(A[0] & 0xffff0000u); y0[2] = __uint_as_float(A[1] << 16); y0[3] = __uint_as_float(A[1] & 0xffff0000u); \
        y1[0] = __uint_as_float(A[2] << 16); y1[1] = __uint_as_float(A[2] & 0xffff0000u); y1[2] = __uint_as_float(A[3] << 16); y1[3] = __uint_as_float(A[3] & 0xffff0000u); \
        *(f32x4*)(dst + (size_t)(ROW) * DM + (OFF)) = y0 * (R) * (G0); *(f32x4*)(dst + (size_t)(ROW) * DM + (OFF) + 4) = y1 * (R) * (G1); } while (0)
        FN_OUT(a0, r0, row, lane * 8, gv[0], gv[1]); FN_OUT(a1, r0, row, 512 + lane * 8, gv[2], gv[3]);
        if (row2 != row) { FN_OUT(b0, r1, row2, lane * 8, gv[0], gv[1]); FN_OUT(b1, r1, row2, 512 + lane * 8, gv[2], gv[3]); }
#undef FN_OUT
    }
}
__device__ __forceinline__ void shiftw_rows(const bf16_t* __restrict__ Wt, const float* __restrict__ mod, float* __restrict__ shw) {
    const int lane = threadIdx.x & 63, gw = blockIdx.x * 8 + (threadIdx.x >> 6), nw = gridDim.x * 8;
    for (int l = 0; l < 2; ++l) {
        f32x4 sh[8][4];
#pragma unroll
        for (int b = 0; b < 8; ++b) { const float* sp = mod + (size_t)(l * 9 + b) * 6144 + 3 * 1024 + lane * 8;
            sh[b][0] = *(const f32x4*)sp; sh[b][1] = *(const f32x4*)(sp + 4); sh[b][2] = *(const f32x4*)(sp + 512); sh[b][3] = *(const f32x4*)(sp + 516); }
        for (int n = gw; n < 2 * DFF; n += nw) {
            const bf16_t* wp = Wt + ((size_t)l * 2 * DFF + n) * DM + lane * 8;
            const u32x4 w0 = *(const u32x4*)wp, w1 = *(const u32x4*)(wp + 512);
            float wf[16];
#pragma unroll
            for (int q = 0; q < 4; ++q) { wf[2 * q] = __uint_as_float(w0[q] << 16); wf[2 * q + 1] = __uint_as_float(w0[q] & 0xffff0000u);
                                          wf[8 + 2 * q] = __uint_as_float(w1[q] << 16); wf[8 + 2 * q + 1] = __uint_as_float(w1[q] & 0xffff0000u); }
            float r[8];
#pragma unroll
            for (int b = 0; b < 8; ++b) { float s = 0.f;
#pragma unroll
                for (int q = 0; q < 4; ++q) s += (sh[b][q][0] * wf[4 * q] + sh[b][q][1] * wf[4 * q + 1]) + (sh[b][q][2] * wf[4 * q + 2] + sh[b][q][3] * wf[4 * q + 3]);
                r[b] = wave_sum(s); }
            if (lane < 8) { float v = r[0];
#pragma unroll
                for (int b = 1; b < 8; ++b) v = (lane == b) ? r[b] : v;
                shw[((size_t)l * 8 + lane) * (2 * DFF) + n] = v; }
        }
    }
}

constexpr int N_GEMV = 96, N_TR = 5120 / 4, N_FPOS = 0, N_CS = 4, N_ROPE = 1;
constexpr int IT_TR = N_GEMV, IT_FPOS = IT_TR + N_TR, IT_CS = IT_FPOS + N_FPOS, IT_ROPE = IT_CS + N_CS, N_ITEMS = IT_ROPE + N_ROPE;
__device__ __forceinline__ void phase_prep(const Params& p, LAS unsigned char* lds) {
    const int tid = threadIdx.x;
    unsigned char* ws = p.ws;
    LAS float* tab = (LAS float*)(lds + 114688);
    for (int i = tid; i < 4096; i += 512) tab[i] = __builtin_amdgcn_cosf((float)i * (1.0f / 4096.0f)) * (1.0f / 64.0f);
    __syncthreads();
    for (int it = blockIdx.x; it < N_ITEMS; it += gridDim.x) {
        if (it < IT_TR) {
            const int layer = it / 48, col0 = (it % 48) * 128;
            LAS float* sv = (LAS float*)lds; LAS float* red = (LAS float*)(lds + 36864);
            for (int i = tid; i < 9216; i += 512) { const int r = i >> 10, k = i & 1023; const float x = (r < 8) ? p.c[r * 1024 + k] : p.c_ctx[k]; sv[i] = x / (1.0f + __expf(-x)); }
            __syncthreads();
            const int kk = tid >> 5, c4 = tid & 31;
            const float* W = p.w_mod + (size_t)layer * 1024 * 6144 + col0 + c4 * 4;
            f32x4 acc[9];
#pragma unroll
            for (int r = 0; r < 9; ++r) acc[r] = (f32x4){0.f, 0.f, 0.f, 0.f};
#pragma unroll 4
            for (int i = 0; i < 64; ++i) { const int k = kk + 16 * i; const f32x4 w = *(const f32x4*)(W + (size_t)k * 6144);
#pragma unroll
                for (int r = 0; r < 9; ++r) acc[r] += w * sv[r * 1024 + k]; }
#pragma unroll
            for (int r = 0; r < 9; ++r) *(LAS f32x4*)(red + (kk * 9 + r) * 128 + c4 * 4) = acc[r];
            __syncthreads();
            float* mod = (float*)(ws + WS_MOD);
            for (int o = tid; o < 1152; o += 512) { const int r = o >> 7, ci = o & 127; float s = p.b_mod[layer * 6144 + col0 + ci];
                for (int q = 0; q < 16; ++q) s += red[(q * 9 + r) * 128 + ci];
                mod[(size_t)(layer * 9 + r) * 6144 + col0 + ci] = s; }
            __syncthreads();
        } else if (it < IT_FPOS) {
            LAS float* tile = (LAS float*)lds;
            const float* src; bf16_t* dst; int K, N, mode, t0;
#define TR_JOB(tt) do { int t = (tt); mode = 0; \
            if (t < 384) { src = p.w_qkv; dst = (bf16_t*)(ws + WS_WQKV); K = 1024; N = NQKV; mode = 1; } \
            else if (t < 640) { t -= 384; src = p.w_o; dst = (bf16_t*)(ws + WS_WO); K = 1024; N = 1024; } \
            else if (t < 896) { t -= 640; src = p.w_f; dst = (bf16_t*)(ws + WS_WF); K = 1024; N = 1024; } \
            else if (t < 2304) { t -= 896; src = p.w_gu; dst = (bf16_t*)(ws + WS_WGU); K = 1024; N = 2 * DFF; mode = 2; } \
            else if (t < 3712) { t -= 2304; src = p.w_gu + (size_t)1024 * 2 * DFF; dst = (bf16_t*)(ws + WS_WGU) + (size_t)2 * DFF * 1024; K = 1024; N = 2 * DFF; mode = 2; } \
            else if (t < 4416) { t -= 3712; src = p.w_d; dst = (bf16_t*)(ws + WS_WD); K = DFF; N = 1024; } \
            else { t -= 4416; src = p.w_d + (size_t)DFF * 1024; dst = (bf16_t*)(ws + WS_WD) + (size_t)1024 * DFF; K = DFF; N = 1024; } t0 = t; } while (0)
            TR_JOB((it - IT_TR) * 4);
            const int nkt = K / 64;
#pragma unroll
            for (int q = 0; q < 4; ++q) { const int t = t0 + q, kb = (t % nkt) * 64, n0 = (t / nkt) * 64;
                const int col = tid & 63, k0 = tid >> 6, np = n0 + col; int sc = np;
                if (mode == 1 && np < 1280) { const int i = np & 127; sc = (np & ~127) + (i >> 1) + 64 * (i & 1); }
                if (mode == 2) { const int r = np & 255, pn = np >> 8; sc = (r >> 7) * DFF + pn * 128 + (r & 127); }
#pragma unroll
                for (int i = 0; i < 8; ++i) { const int k = k0 + 8 * i; tile[q * 4160 + k * 65 + col] = src[(size_t)(kb + k) * N + sc]; } }
            __syncthreads();
#pragma unroll
            for (int q = 0; q < 4; ++q) { const int t = t0 + q, kb = (t % nkt) * 64, n0 = (t / nkt) * 64;
                const int nl = tid >> 3, ks = (tid & 7) * 8; float v[8];
#pragma unroll
                for (int j = 0; j < 8; ++j) v[j] = tile[q * 4160 + (ks + j) * 65 + nl];
                u32x4 w; w.x = cvtpk(v[0], v[1]); w.y = cvtpk(v[2], v[3]); w.z = cvtpk(v[4], v[5]); w.w = cvtpk(v[6], v[7]);
                *(u32x4*)(dst + (size_t)(n0 + nl) * K + kb + ks) = w; }
            __syncthreads();
#undef TR_JOB
        } else if (it < IT_ROPE) {
            const int q = it - IT_CS; bf16_t* CS = (bf16_t*)(ws + WS_CS);
            for (int s = 0; s < 8; ++s) { const int idx = s * 512 + tid, l = 64 * q + (idx >> 6), cc = (idx & 63) * 8, cs = cc >> 8, c0 = cc & 255; float v[8];
#pragma unroll
                for (int e = 0; e < 8; ++e) { const int m = (l * (c0 + e)) & 255; const int id = cs ? ((m * 16 - 1024) & 4095) : (m * 16); v[e] = 4.0f * tab[id]; }
                u32x4 w; w.x = cvtpk(v[0], v[1]); w.y = cvtpk(v[2], v[3]); w.z = cvtpk(v[4], v[5]); w.w = cvtpk(v[6], v[7]);
                *(u32x4*)(CS + (size_t)l * 512 + cc) = w; }
        } else {
            float* T = (float*)(ws + WS_ROPE);
            for (int i = tid; i < 2048; i += 512) { const int pos = i >> 5, f = i & 31;
                const float inv = __builtin_amdgcn_exp2f(-(float)f * (13.287712379549449f / 32.0f));
                const float ang = (float)pos * inv, rev = ang * 0.15915494309189535f, fr = rev - rintf(rev);
                T[2 * i] = __builtin_amdgcn_cosf(fr); T[2 * i + 1] = __builtin_amdgcn_sinf(fr); }
        }
    }
}

#define XB_TMO      128
#define XB_XCNT(j)  (256  + 64 * (j))
#define XB_XSUB(j)  (1280 + 64 * (j))
#define XB_XGEN(j)  (2304 + 64 * (j))
#define XB_TOP      3328
#define XB_TOPGEN   3392
#define XB_SPIN_CAP (1u << 20)
__device__ __forceinline__ unsigned xb_ld(unsigned* p)              { return __hip_atomic_load(p, __ATOMIC_RELAXED, __HIP_MEMORY_SCOPE_AGENT); }
__device__ __forceinline__ unsigned xb_add(unsigned* p, unsigned v) { return __hip_atomic_fetch_add(p, v, __ATOMIC_RELAXED, __HIP_MEMORY_SCOPE_AGENT); }
__device__ __forceinline__ unsigned xb_xcc_id() { return (unsigned)__builtin_amdgcn_s_getreg((3 << 11) | 20) & 0xFu; }
#define XB_SPIN(cond, bar) do { unsigned _sp = 0; while (cond) { __builtin_amdgcn_s_sleep(1); \
    if ((++_sp & 255u) == 0u) { if (xb_ld(&(bar)[XB_TMO])) break; if (_sp > XB_SPIN_CAP) { atomicAdd(&(bar)[XB_TMO], 1u); break; } } } } while (0)
struct XcdBarrier { unsigned* bar; unsigned x; volatile LAS unsigned* st; };
__device__ __forceinline__ XcdBarrier xcd_barrier_post(unsigned* bar, volatile LAS unsigned* st) {
    XcdBarrier b; b.bar = bar; b.x = xb_xcc_id(); b.st = st;
    if (threadIdx.x == 0) (void)xb_add(&bar[XB_XCNT(b.x)], 1u);
    return b;
}
__device__ __forceinline__ void xcd_barrier_complete(unsigned* bar, unsigned x, unsigned& nloc, unsigned& nx) {
    const unsigned G = gridDim.x * gridDim.y * gridDim.z;
    unsigned sum, cnt, mine, sp = 0u;
    for (;;) {
        sum = 0u; cnt = 0u; mine = 0u;
#pragma unroll
        for (unsigned j = 0; j < 16; ++j) { const unsigned c = xb_ld(&bar[XB_XCNT(j)]); sum += c; cnt += (c > 0u) ? 1u : 0u; mine = (j == x) ? c : mine; }
        if (sum == G) break;
        __builtin_amdgcn_s_sleep(1);
        if ((++sp & 255u) == 0u) { if (xb_ld(&bar[XB_TMO])) break; if (sp > XB_SPIN_CAP) { atomicAdd(&bar[XB_TMO], 1u); break; } }
    }
    nloc = mine > 0u ? mine : 1u; nx = cnt > 0u ? cnt : 1u;
}
__device__ __forceinline__ void xcd_barrier(const XcdBarrier& b) {
    asm volatile("s_waitcnt vmcnt(0)" ::: "memory");
    __syncthreads();
    if (threadIdx.x == 0) {
        unsigned* bar = b.bar;
        __builtin_amdgcn_s_waitcnt(0);
        unsigned nloc = b.st[0], nx = b.st[1];
        if (nloc == 0u) { xcd_barrier_complete(bar, b.x, nloc, nx); b.st[0] = nloc; b.st[1] = nx; }
        const unsigned old = xb_add(&bar[XB_XSUB(b.x)], 1u);
        const unsigned gen = old / nloc;
        if (old + 1u == (gen + 1u) * nloc) {
            __builtin_amdgcn_fence(__ATOMIC_RELEASE, "agent");
            asm volatile("s_waitcnt vmcnt(0)" ::: "memory");
            const unsigned og = xb_add(&bar[XB_TOP], 1u);
            const unsigned tg = og / nx;
            if (og + 1u == (tg + 1u) * nx) xb_add(&bar[XB_TOPGEN], 1u);
            else XB_SPIN(xb_ld(&bar[XB_TOPGEN]) == tg, bar);
            __builtin_amdgcn_fence(__ATOMIC_ACQUIRE, "agent");
            xb_add(&bar[XB_XGEN(b.x)], 1u);
            asm volatile("s_waitcnt vmcnt(0)" ::: "memory");
        } else {
            XB_SPIN(xb_ld(&bar[XB_XGEN(b.x)]) == gen, bar);
            __builtin_amdgcn_fence(__ATOMIC_ACQUIRE, "agent");
            asm volatile("s_waitcnt vmcnt(0)" ::: "memory");
        }
    }
    __syncthreads();
}

constexpr int N_PHASES = 17;
__global__ void __launch_bounds__(512, 2) k_all(Params p, int ph_lo, int ph_hi) {
    extern __shared__ __attribute__((aligned(16))) unsigned char lds_raw[];
    LAS unsigned char* lds = (LAS unsigned char*)lds_raw;
    unsigned char* ws = p.ws;
    const int G = gridDim.x, c = blockIdx.x;
    bf16_t* X = (bf16_t*)(ws + WS_X); bf16_t* H = (bf16_t*)(ws + WS_H); const float* mod = (const float*)(ws + WS_MOD);
#define IN(k) (ph_lo <= (k) && (k) < ph_hi)
    volatile LAS unsigned* bst = (volatile LAS unsigned*)(lds + BARLDS_OFF);
    XcdBarrier xbar; xbar.bar = (unsigned*)(ws + WS_BAR); xbar.x = 0; xbar.st = bst;
    if (ph_hi - ph_lo > 1) {
        if (threadIdx.x == 0) { bst[0] = 0u; bst[1] = 0u; }
        __syncthreads();
        xbar = xcd_barrier_post((unsigned*)(ws + WS_BAR), bst);
    }
    if (ph_lo < 0) cg::this_grid().sync();
#define SEAM(k) do { if (IN(k) && IN((k) + 1)) xcd_barrier(xbar); } while (0)
    if (IN(0)) phase_prep(p, lds);
    SEAM(0);
    if (IN(1)) {
        normmod_rows(p.x, H, p.g_mix, mod, 0, MTOK, 12, 0);
        normmod_rows(p.ctx, H + (size_t)MTOK * DM, p.g_mix, mod, 0, MCTX, 30, 8);
        shiftw_rows((const bf16_t*)(ws + WS_WGU), mod, (float*)(ws + WS_SHW));
    }
    SEAM(1);
    if (IN(2)) {
        ProbPlain g{(const char*)H, (const char*)(ws + WS_WQKV), DM, DM, DM}; QkvOrder S{G, c};
        EpiQKV E{(bf16_t*)(ws + WS_Q), (bf16_t*)(ws + WS_K), (bf16_t*)(ws + WS_V), p.g_q, p.g_k, (const float*)(ws + WS_ROPE)};
        gemm_phase<EpiQKV, QkvOrder, ProbPlain>(lds, g, S, E);
    }
    SEAM(2);
    if (IN(3)) {
        const int vcu = (G % 8 == 0) ? (c % 8) * (G / 8) + c / 8 : c;
        const bf16_t* Q = (const bf16_t*)(ws + WS_Q); const bf16_t* Kc = (const bf16_t*)(ws + WS_K); const bf16_t* Vc = (const bf16_t*)(ws + WS_V); bf16_t* O = (bf16_t*)(ws + WS_O);
        float gqm = 0.f, gkm = 0.f;
        for (int i = 0; i < HD; ++i) { gqm = fmaxf(gqm, fabsf(p.g_q[i])); gkm = fmaxf(gkm, fabsf(p.g_k[i])); }
        const float mnC = -(SCALE * 1.4426950408889634f) * (float)HD * gqm * gkm;
        for (int v = vcu; v < NBATCH * NHEAD * (SEQ / 256); v += G) {
            const int grp = v >> 6, w = v & 63, b = grp >> 1, kvh = grp & 1, h = kvh * 4 + (w >> 4), qb = w & 15;
            const size_t qoff = ((size_t)(b * SEQ + qb * 256)) * DM + h * HD, koff = ((size_t)(b * NKVH + kvh) * SKV) * HD;
            attn_dense_body(Q + qoff, Kc + koff, Vc + koff, O + qoff, SKV, (char*)lds_raw, lds, mnC);
            __syncthreads();
        }
    }
    SEAM(3);
    if (IN(4)) {
        ProbPlain g{(const char*)(ws + WS_O), (const char*)(ws + WS_WO), DM, DM, DM}; StaticOrder S{MTOK / 256, DM / 256, G, c};
        EpiResB<true> E{p.x, X, mod + 2 * 1024, nullptr, H, (float*)(ws + WS_SSQ), p.g_ffn, mod + 4 * 1024};
        gemm_phase<EpiResB<true>, StaticOrder, ProbPlain>(lds, g, S, E);
    }
    SEAM(4);
    if (IN(5)) {
        ProbPlain g{(const char*)H, (const char*)(ws + WS_WGU), DM, DM, DM}; StaticOrder S{MTOK / 256, 2 * DFF / 256, G, c};
        EpiSwiGLU2 E{(bf16_t*)(ws + WS_ACT), (const float*)(ws + WS_SSQ), (const float*)(ws + WS_SHW)};
        rstd_prestep(S, (const float*)(ws + WS_SSQ), E.shw, (LAS float*)(lds + XLDS_OFF));
        gemm_phase<EpiSwiGLU2, StaticOrder, ProbPlain>(lds, g, S, E);
    }
    SEAM(5);
    if (IN(7)) {
        ProbPlain g{(const char*)(ws + WS_ACT), (const char*)(ws + WS_WD), DFF, DFF, DFF}; StaticOrder S{MTOK / 256, DM / 256, G, c};
        EpiResB<false> E{X, X, mod + 5 * 1024, nullptr, nullptr, (float*)(ws + WS_SSQ), nullptr, nullptr};
        gemm_phase<EpiResB<false>, StaticOrder, ProbPlain>(lds, g, S, E);
    }
    SEAM(7);
    if (IN(9)) phase_fft1(X, (const float*)(ws + WS_SSQ), p.g_mix + DM, mod + 9 * 6144, (bf16_t*)(ws + WS_AP), (char*)lds_raw);
    SEAM(9);
    if (IN(10)) phase_fft3((const bf16_t*)(ws + WS_AP), (bf16_t*)(ws + WS_Z), (char*)lds_raw);
    SEAM(10);
    if (IN(11)) {
        ProbCh g{(const char*)(ws + WS_Z), (const char*)(ws + WS_CS), 2048, 512, 512}; StaticOrder S{MTOK / 256, DM / 256, G, c};
        EpiBf16 E{H};
        gemm_phase<EpiBf16, StaticOrder, ProbCh>(lds, g, S, E);
    }
    SEAM(11);
    if (IN(12)) {
        ProbPlain g{(const char*)H, (const char*)(ws + WS_WF), DM, DM, DM}; StaticOrder S{MTOK / 256, DM / 256, G, c};
        EpiResB<false> E{X, X, mod + 9 * 6144 + 2 * 1024, p.b_f, (bf16_t*)(ws + WS_XG1), (float*)(ws + WS_SSQ), p.g_ffn + DM, mod + 9 * 6144 + 4 * 1024};
        gemm_phase<EpiResB<false>, StaticOrder, ProbPlain>(lds, g, S, E);
    }
    SEAM(12);
    if (IN(13)) {
        ProbPlain g{(const char*)(ws + WS_XG1), (const char*)(ws + WS_WGU) + (size_t)2 * DFF * DM * 2, DM, DM, DM}; StaticOrder S{MTOK / 256, 2 * DFF / 256, G, c};
        EpiSwiGLU2 E{(bf16_t*)(ws + WS_ACT), (const float*)(ws + WS_SSQ), (const float*)(ws + WS_SHW) + (size_t)8 * 2 * DFF};
        rstd_prestep(S, (const float*)(ws + WS_SSQ), E.shw, (LAS float*)(lds + XLDS_OFF));
        gemm_phase<EpiSwiGLU2, StaticOrder, ProbPlain>(lds, g, S, E);
    }
    SEAM(13);
    if (IN(15)) {
        ProbPlain g{(const char*)(ws + WS_ACT), (const char*)(ws + WS_WD) + (size_t)DM * DFF * 2, DFF, DFF, DFF}; StaticOrder S{MTOK / 256, DM / 256, G, c};
        EpiFinal E{X, mod + 9 * 6144 + 5 * 1024, p.g_final, p.out, (float*)(ws + WS_EXCH), (unsigned*)(ws + WS_BAR) + 3456};
        gemm_phase<EpiFinal, StaticOrder, ProbPlain>(lds, g, S, E);
    }
#undef IN
#undef SEAM
}

extern "C" void kernel_launch(void* const* d_in, const int* in_sizes, int n_in, void* d_out, int out_size, void* d_ws, size_t ws_size, hipStream_t stream) {
    static int grid = 0;
    if (grid == 0) {
        if (n_in != 17 || in_sizes[0] != MTOK * DM || out_size != MTOK * DM || ws_size < WS_END) {
            fprintf(stderr, "kernel_launch: shape/workspace mismatch: n_in %d in0 %d out %d ws %zu (need %zu)\n", n_in, n_in > 0 ? in_sizes[0] : -1, out_size, ws_size, (size_t)WS_END); grid = -1; return; }
        int dev = 0, cus = 0, per_cu = 0;
        if (hipGetDevice(&dev) != hipSuccess || hipDeviceGetAttribute(&cus, hipDeviceAttributeMultiprocessorCount, dev) != hipSuccess) { grid = -1; return; }
        if (hipFuncSetAttribute((const void*)k_all, hipFuncAttributeMaxDynamicSharedMemorySize, LDS_BYTES) != hipSuccess) { fprintf(stderr, "kernel_launch: hipFuncSetAttribute failed\n"); grid = -1; return; }
        if (hipOccupancyMaxActiveBlocksPerMultiprocessor(&per_cu, (const void*)k_all, 512, LDS_BYTES) != hipSuccess || per_cu < 1) { fprintf(stderr, "kernel_launch: occupancy query failed (%d)\n", per_cu); grid = -1; return; }
        grid = cus * per_cu;
    }
    if (grid < 0) return;
    Params p{};
    p.x = (const float*)d_in[0]; p.c = (const float*)d_in[1]; p.ctx = (const float*)d_in[2]; p.c_ctx = (const float*)d_in[3]; p.w_mod = (const float*)d_in[4]; p.b_mod = (const float*)d_in[5];
    p.g_mix = (const float*)d_in[6]; p.g_ffn = (const float*)d_in[7]; p.w_qkv = (const float*)d_in[8]; p.g_q = (const float*)d_in[9]; p.g_k = (const float*)d_in[10]; p.w_o = (const float*)d_in[11];
    p.w_f = (const float*)d_in[12]; p.b_f = (const float*)d_in[13]; p.w_gu = (const float*)d_in[14]; p.w_d = (const float*)d_in[15]; p.g_final = (const float*)d_in[16];
    p.out = (float*)d_out; p.ws = (unsigned char*)d_ws;
    if (hipMemsetAsync((unsigned char*)d_ws + WS_BAR, 0, BAR_BYTES, stream) != hipSuccess) { fprintf(stderr, "kernel_launch: memset of the barrier words failed\n"); return; }
#if MK_COOP
    int lo = 0, hi = N_PHASES;
    void* args[] = {&p, &lo, &hi};
    hipError_t e = hipLaunchCooperativeKernel((const void*)k_all, dim3(grid), dim3(512), args, LDS_BYTES, stream);
    if (e != hipSuccess) fprintf(stderr, "kernel_launch: cooperative launch failed: %s (grid %d)\n", hipGetErrorString(e), grid);
#else
    for (int ph = 0; ph < N_PHASES; ++ph) hipLaunchKernelGGL(k_all, dim3(grid), dim3(512), LDS_BYTES, stream, p, ph, ph + 1);
    hipError_t e = hipPeekAtLastError();
    if (e != hipSuccess) fprintf(stderr, "kernel_launch: launch failed: %s\n", hipGetErrorString(e));
#endif
}
```

```cpp
#include <hip/hip_runtime.h>
#include <hip/hip_cooperative_groups.h>
#include <cstdio>
#include <cstdint>
namespace cg = cooperative_groups;

#ifndef MK_COOP
#define MK_COOP 1
#endif

#define LAS __attribute__((address_space(3)))
typedef unsigned short bf16_t;
typedef short bf16x8 __attribute__((ext_vector_type(8)));
typedef short s16x4 __attribute__((ext_vector_type(4)));
typedef float f32x4 __attribute__((ext_vector_type(4)));
typedef float f32x16 __attribute__((ext_vector_type(16)));
typedef unsigned u32x4 __attribute__((ext_vector_type(4)));
typedef unsigned u32x2 __attribute__((ext_vector_type(2)));

constexpr int DM = 1024, NBATCH = 8, SEQ = 4096, CTXL = 256, DFF = 2816, NHEAD = 8, NKVH = 2, HD = 128, SKV = SEQ + CTXL;
constexpr int MTOK = NBATCH * SEQ, MCTX = NBATCH * CTXL, MALL = MTOK + MCTX, NQKV = DM + 2 * NKVH * HD;
constexpr float EPSN = 1e-6f;

constexpr size_t al256(size_t x) { return (x + 255) / 256 * 256; }
constexpr size_t WS_WQKV = 0;
constexpr size_t WS_WO   = WS_WQKV + (size_t)NQKV * DM * 2;
constexpr size_t WS_WF   = WS_WO + (size_t)DM * DM * 2;
constexpr size_t WS_WGU  = WS_WF + (size_t)DM * DM * 2;
constexpr size_t WS_WD   = WS_WGU + (size_t)2 * 2 * DFF * DM * 2;
constexpr size_t WS_CS   = WS_WD + (size_t)2 * DM * DFF * 2;
constexpr size_t WS_MOD  = WS_CS + (size_t)512 * 256 * 2;
constexpr size_t WS_ROPE = WS_MOD + (size_t)2 * 9 * 6144 * 4;
constexpr size_t WS_H    = al256(WS_ROPE + 64 * 32 * 2 * 4);
constexpr size_t WS_X    = WS_H + (size_t)MALL * DM * 2;
constexpr size_t WS_R    = WS_X + (size_t)MTOK * DM * 4;
constexpr size_t WS_Q    = WS_R;
constexpr size_t WS_K    = WS_Q + (size_t)MTOK * DM * 2;
constexpr size_t WS_V    = WS_K + (size_t)NBATCH * NKVH * SKV * HD * 2;
constexpr size_t WS_O    = WS_V + (size_t)NBATCH * NKVH * SKV * HD * 2;
constexpr size_t WS_ACT  = WS_R;
constexpr size_t WS_AP   = WS_R;
constexpr size_t WS_Z    = WS_R + (size_t)MTOK * DM * 2 * 2;
constexpr size_t WS_BAR  = WS_Z + (size_t)MTOK * DM * 2 * 2;
constexpr size_t BAR_BYTES = 16384;
constexpr size_t WS_SSQ  = WS_BAR + 16384;
constexpr size_t WS_SHW  = WS_SSQ + (size_t)MTOK * 16 * 4;
constexpr size_t WS_XG1  = WS_R + (size_t)192 * 1024 * 1024;
constexpr size_t WS_EXCH = WS_SHW + (size_t)2 * 8 * 2 * DFF * 4;
constexpr size_t WS_END  = WS_EXCH + (size_t)MTOK * 4 * 4;
static_assert(WS_XG1 >= WS_ACT + (size_t)MTOK * DFF * 2 && WS_XG1 + (size_t)MTOK * DM * 2 <= WS_BAR && WS_O + (size_t)MTOK * DM * 2 <= WS_END && WS_ACT + (size_t)MTOK * DFF * 2 <= WS_END && WS_END <= (size_t)536870912, "union region");

constexpr int STAGE_BYTES = 131072, XLDS_OFF = STAGE_BYTES, BARLDS_OFF = STAGE_BYTES + 24576, LDS_BYTES = STAGE_BYTES + 24576 + 16;

struct Params {
    const float *x, *c, *ctx, *c_ctx, *w_mod, *b_mod, *g_mix, *g_ffn, *w_qkv, *g_q, *g_k, *w_o, *w_f, *b_f, *w_gu, *w_d, *g_final;
    float* out; unsigned char* ws;
};

typedef __bf16 bf16x2_n __attribute__((ext_vector_type(2)));
typedef float f32x2_n __attribute__((ext_vector_type(2)));
__device__ __forceinline__ unsigned cvtpk(float lo, float hi) { f32x2_n v = {lo, hi}; bf16x2_n b = __builtin_convertvector(v, bf16x2_n); return *reinterpret_cast<unsigned*>(&b); }

constexpr int BM = 256, BK = 64, HALF = 128, HTB = HALF * BK * 2, NXCD = 8, WGM = 8;
__host__ __device__ __forceinline__ int lds_byte(int r, int c) { const int st = (r >> 4) * 2 + (c >> 5), rr = r & 15, cc = c & 31, ob = rr * 64 + cc * 2; return st * 1024 + (ob ^ (((ob >> 9) & 1) << 5)); }
__host__ __device__ __forceinline__ void stage_rc(int b, int& R, int& C) { const int st = b / 1024, sb = b % 1024, swz = sb ^ (((sb >> 9) & 1) << 5); R = (st >> 1) * 16 + swz / 64; C = (st & 1) * 32 + (swz % 64) / 2; }
__host__ __device__ __forceinline__ int perm32(int rho) { const int n = rho >> 4, i = rho & 15; return 8 * (i >> 2) + 4 * n + (i & 3); }

struct Unit { int pm, pn; };
__device__ __forceinline__ void tile_map(int wgid, int nM, int nN, Unit& u) {
    const int nwg = nM * nN;
    { const int q = nwg / NXCD, r = nwg % NXCD, xcd = wgid % NXCD, off = wgid / NXCD; wgid = (xcd < r ? xcd * (q + 1) : r * (q + 1) + (xcd - r) * q) + off; }
    const int nig = WGM * nN, gid = wgid / nig, fm = gid * WGM, gsz = (nM - fm) < WGM ? (nM - fm) : WGM;
    u.pm = fm + ((wgid % nig) % gsz); u.pn = (wgid % nig) / gsz;
}
struct StaticOrder {
    int nM, nN, G, c;
    __device__ __forceinline__ bool next(int i, Unit& u) const { const long L = (long)i * G + c; if (L >= (long)nM * nN) return false; tile_map((int)L, nM, nN, u); return true; }
};
struct QkvOrder {
    int G, c;
    __device__ __forceinline__ bool next(int i, Unit& u) const {
        const long L = (long)i * G + c;
        if (L < 768) { tile_map((int)L, 128, 6, u); return true; }
        if (L < 784) { const int e = (int)L - 768; u.pm = 128 + (e >> 1); u.pn = 4 + (e & 1); return true; }
        return false;
    }
};
struct ProbPlain {
    const char* A; const char* B; unsigned lda, ldb; int K;
    __device__ __forceinline__ const char* a(const Unit& u) const { return A + (size_t)u.pm * 256 * lda * 2; }
    __device__ __forceinline__ const char* b(const Unit& u) const { return B + (size_t)u.pn * 256 * ldb * 2; }
};
struct ProbCh {
    const char* A; const char* B; unsigned lda, ldb; int K;
    __device__ __forceinline__ const char* a(const Unit& u) const { return A + ((size_t)u.pm * 256 * 2048 + (size_t)u.pn * 512) * 2; }
    __device__ __forceinline__ const char* b(const Unit&) const { return B; }
};

template <class Epi, class Sched, class Prob>
__device__ __forceinline__ void gemm_phase(LAS unsigned char* lds, const Prob g, const Sched& S, const Epi& E) {
    const int tid = threadIdx.x, wid = __builtin_amdgcn_readfirstlane(tid >> 6), lane = tid & 63, wr = wid >> 2, wc = wid & 3, fr = lane & 15, fq = lane >> 4;
    const int nt = g.K / BK;
    unsigned voffA[2], voffB[2];
#pragma unroll
    for (int i = 0; i < 2; ++i) { int R, C; stage_rc(tid * 16 + i * 8192, R, C); const int Rb = Epi::PERM ? ((R & ~31) + perm32(R & 31)) : R;
        voffA[i] = (unsigned)(R * g.lda + C) * 2u; voffB[i] = (unsigned)(Rb * g.ldb + C) * 2u; }
    const size_t kstep = (size_t)(BK * 2);
    const size_t hstepA = (size_t)HALF * g.lda * 2, hstepB = (size_t)HALF * g.ldb * 2;
    const unsigned ldsw = (unsigned)wid * 1024u;
    const int aoff = lds_byte(wr * 64 + fr, fq * 8), boff = lds_byte(wc * 32 + fr, fq * 8);
    LAS float* xlds = (LAS float*)(lds + XLDS_OFF);
#define PG8_SA(b, h) (((b) * 2 + (h)) * HTB)
#define PG8_SB(b, h) ((4 + (b) * 2 + (h)) * HTB)
#define PG8_STAGE(bufoff, gbase, voff) do { _Pragma("unroll") for (int _i = 0; _i < 2; ++_i) \
        __builtin_amdgcn_global_load_lds((const unsigned*)((const char*)(gbase) + (voff)[_i]), (LAS unsigned*)(lds + (bufoff) + ldsw + _i * 8192), 16, 0, 0); } while (0)
#define PG8_LDA(dst, b, h) do { _Pragma("unroll") for (int m = 0; m < 4; ++m) _Pragma("unroll") for (int k = 0; k < 2; ++k) dst[m][k] = *(const LAS bf16x8*)(lds + PG8_SA(b, h) + aoff + m * 2048 + k * 1024); } while (0)
#define PG8_LDB(dst, b, h) do { _Pragma("unroll") for (int n = 0; n < 2; ++n) _Pragma("unroll") for (int k = 0; k < 2; ++k) dst[n][k] = *(const LAS bf16x8*)(lds + PG8_SB(b, h) + boff + n * 2048 + k * 1024); } while (0)
#define PG8_MMA(ai, bj, At, Bt) do { __builtin_amdgcn_s_setprio(1); _Pragma("unroll") for (int m = 0; m < 4; ++m) _Pragma("unroll") for (int n = 0; n < 2; ++n) _Pragma("unroll") for (int k = 0; k < 2; ++k) \
        acc[ai][bj][m][n] = __builtin_amdgcn_mfma_f32_16x16x32_bf16(Bt[n][k], At[m][k], acc[ai][bj][m][n], 0, 0, 0); __builtin_amdgcn_s_setprio(0); } while (0)
#define PG8_WAIT_V(n) asm volatile("s_waitcnt vmcnt(" #n ")" ::: "memory")
#define PG8_WAIT_L(n) asm volatile("s_waitcnt lgkmcnt(" #n ")" ::: "memory")
#define PG8_BAR __builtin_amdgcn_s_barrier()
#define PG8_SCHED __builtin_amdgcn_sched_barrier(0)
    Unit cur, nxt; int ui = 0;
    if (!S.next(0, cur)) return;
    f32x4 acc[2][2][4][2];
#pragma unroll
    for (int a = 0; a < 2; ++a)
#pragma unroll
        for (int b = 0; b < 2; ++b)
#pragma unroll
            for (int m = 0; m < 4; ++m)
#pragma unroll
                for (int n = 0; n < 2; ++n) acc[a][b][m][n] = (f32x4){0.f, 0.f, 0.f, 0.f};
    bf16x8 At[4][2], B0[2][2], B1[2][2];
    const char* cA = g.a(cur); const char* cB = g.b(cur);
    PG8_STAGE(PG8_SB(0, 0), cB, voffB); PG8_STAGE(PG8_SB(0, 1), cB + hstepB, voffB); PG8_STAGE(PG8_SA(0, 0), cA, voffA); PG8_STAGE(PG8_SA(0, 1), cA + hstepA, voffA);
    if (wr == 1) PG8_BAR;
    PG8_WAIT_V(2); PG8_BAR;
    PG8_STAGE(PG8_SB(1, 0), cB + kstep, voffB); PG8_STAGE(PG8_SA(1, 0), cA + kstep, voffA); PG8_STAGE(PG8_SB(1, 1), cB + hstepB + kstep, voffB);
    PG8_WAIT_V(6); PG8_BAR;
    for (;;) {
        const bool has_next = S.next(ui + 1, nxt);
        const char* nA = has_next ? g.a(nxt) : cA; const char* nB = has_next ? g.b(nxt) : cB;
#pragma unroll 1
        for (int t = 0; t < nt; t += 2) {
            const bool last = (t == nt - 2);
            const char* a1 = cA + (size_t)(t + 1) * kstep;
            const char* a2 = last ? nA : cA + (size_t)(t + 2) * kstep; const char* b2 = last ? nB : cB + (size_t)(t + 2) * kstep;
            const char* a3 = a2 + kstep; const char* b3 = b2 + kstep;
            PG8_LDB(B0, 0, 0); PG8_LDB(B1, 0, 1); PG8_SCHED; PG8_LDA(At, 0, 0); PG8_STAGE(PG8_SA(1, 1), a1 + hstepA, voffA);
            PG8_WAIT_V(8); PG8_WAIT_L(0); PG8_BAR; PG8_MMA(0, 0, At, B0); PG8_MMA(0, 1, At, B1); PG8_BAR; PG8_SCHED;
            PG8_LDA(At, 0, 1); PG8_STAGE(PG8_SB(0, 0), b2, voffB); PG8_STAGE(PG8_SB(0, 1), b2 + hstepB, voffB); PG8_STAGE(PG8_SA(0, 0), a2, voffA);
            PG8_WAIT_V(8); PG8_WAIT_L(0); PG8_BAR; PG8_MMA(1, 0, At, B0); PG8_MMA(1, 1, At, B1); PG8_BAR; PG8_SCHED;
            PG8_LDB(B0, 1, 0); PG8_LDB(B1, 1, 1); PG8_SCHED; PG8_LDA(At, 1, 0); PG8_STAGE(PG8_SA(0, 1), a2 + hstepA, voffA);
            PG8_WAIT_V(8); PG8_WAIT_L(0); PG8_BAR; PG8_MMA(0, 0, At, B0); PG8_MMA(0, 1, At, B1); PG8_BAR; PG8_SCHED;
            PG8_LDA(At, 1, 1); PG8_STAGE(PG8_SB(1, 0), b3, voffB); PG8_STAGE(PG8_SB(1, 1), b3 + hstepB, voffB); PG8_STAGE(PG8_SA(1, 0), a3, voffA);
            PG8_WAIT_V(8); PG8_WAIT_L(0); PG8_BAR; PG8_MMA(1, 0, At, B0); PG8_MMA(1, 1, At, B1); PG8_BAR; PG8_SCHED;
        }
        if (wr == 0) PG8_BAR;
        E(acc, cur, wr, wc, fr, fq, xlds, ui);
        if (!has_next) break;
#pragma unroll
        for (int a = 0; a < 2; ++a)
#pragma unroll
            for (int b = 0; b < 2; ++b)
#pragma unroll
                for (int m = 0; m < 4; ++m)
#pragma unroll
                    for (int n = 0; n < 2; ++n) acc[a][b][m][n] = (f32x4){0.f, 0.f, 0.f, 0.f};
        cur = nxt; cA = nA; cB = nB; ++ui;
        if (wr == 1) PG8_BAR;
    }
    PG8_WAIT_V(0);
    PG8_BAR;
#undef PG8_SA
#undef PG8_SB
#undef PG8_STAGE
#undef PG8_LDA
#undef PG8_LDB
#undef PG8_MMA
#undef PG8_WAIT_V
#undef PG8_WAIT_L
#undef PG8_BAR
#undef PG8_SCHED
}

struct EpiResid {
    static constexpr bool PERM = false;
    const float* xin; float* xout; const float* gate; const float* bias;
    __device__ __forceinline__ void operator()(const f32x4 (&acc)[2][2][4][2], const Unit& u, int wr, int wc, int fr, int fq, LAS float*, int) const {
        const int row0 = u.pm * BM + wr * 64 + fr, col0 = u.pn * BM + wc * 32 + 4 * fq;
        const float* gp = gate + (size_t)((u.pm * BM) >> 12) * 6144 + col0;
        f32x4 gv[2][2], bv[2][2];
#pragma unroll
        for (int bj = 0; bj < 2; ++bj)
#pragma unroll
            for (int n = 0; n < 2; ++n) { gv[bj][n] = *(const f32x4*)(gp + bj * HALF + n * 16); bv[bj][n] = bias ? *(const f32x4*)(bias + col0 + bj * HALF + n * 16) : (f32x4){0.f, 0.f, 0.f, 0.f}; }
#pragma unroll
        for (int ai = 0; ai < 2; ++ai)
#pragma unroll
            for (int m = 0; m < 4; ++m) { const size_t off = (size_t)(row0 + ai * HALF + m * 16) * DM + col0;
#pragma unroll
                for (int bj = 0; bj < 2; ++bj)
#pragma unroll
                    for (int n = 0; n < 2; ++n) { const f32x4 xv = *(const f32x4*)(xin + off + bj * HALF + n * 16);
                        *(f32x4*)(xout + off + bj * HALF + n * 16) = xv + gv[bj][n] * (acc[ai][bj][m][n] + bv[bj][n]); } }
    }
};
__device__ __forceinline__ float silu_f(float g) { return g * __builtin_amdgcn_rcpf(1.0f + __expf(-g)); }
struct EpiSwiGLU {
    static constexpr bool PERM = true;
    bf16_t* act;
    __device__ __forceinline__ void operator()(const f32x4 (&acc)[2][2][4][2], const Unit& u, int wr, int wc, int fr, int fq, LAS float*, int) const {
        const int row0 = u.pm * BM + wr * 64 + fr, col0 = u.pn * HALF + wc * 32 + 8 * fq;
#pragma unroll
        for (int ai = 0; ai < 2; ++ai)
#pragma unroll
            for (int m = 0; m < 4; ++m) {
                const f32x4 g0 = acc[ai][0][m][0], g1 = acc[ai][0][m][1], u0 = acc[ai][1][m][0], u1 = acc[ai][1][m][1];
                u32x4 w; w.x = cvtpk(silu_f(g0[0]) * u0[0], silu_f(g0[1]) * u0[1]); w.y = cvtpk(silu_f(g0[2]) * u0[2], silu_f(g0[3]) * u0[3]);
                w.z = cvtpk(silu_f(g1[0]) * u1[0], silu_f(g1[1]) * u1[1]); w.w = cvtpk(silu_f(g1[2]) * u1[2], silu_f(g1[3]) * u1[3]);
                *(u32x4*)(act + (size_t)(row0 + ai * HALF + m * 16) * DFF + col0) = w; }
    }
};
struct EpiResidXg {
    static constexpr bool PERM = false;
    const float* xin; float* xout; const float* gate; const float* bias; bf16_t* xg; float* ssq; const float* gnext; const float* scale;
    __device__ __forceinline__ void operator()(const f32x4 (&acc)[2][2][4][2], const Unit& u, int wr, int wc, int fr, int fq, LAS float*, int) const {
        const int row0 = u.pm * BM + wr * 64 + fr, col0 = u.pn * BM + wc * 32 + 4 * fq, b = (u.pm * BM) >> 12;
        const float* gp = gate + (size_t)b * 6144 + col0; const float* sp = scale + (size_t)b * 6144 + col0;
        f32x4 gv[2][2], bv[2][2], gs[2][2];
#pragma unroll
        for (int bj = 0; bj < 2; ++bj)
#pragma unroll
            for (int n = 0; n < 2; ++n) { gv[bj][n] = *(const f32x4*)(gp + bj * HALF + n * 16); bv[bj][n] = bias ? *(const f32x4*)(bias + col0 + bj * HALF + n * 16) : (f32x4){0.f, 0.f, 0.f, 0.f};
                gs[bj][n] = *(const f32x4*)(gnext + col0 + bj * HALF + n * 16) * (*(const f32x4*)(sp + bj * HALF + n * 16) + 1.0f); }
#pragma unroll
        for (int ai = 0; ai < 2; ++ai)
#pragma unroll
            for (int m = 0; m < 4; ++m) { const int row = row0 + ai * HALF + m * 16; const size_t off = (size_t)row * DM + col0; float s = 0.f;
#pragma unroll
                for (int bj = 0; bj < 2; ++bj)
#pragma unroll
                    for (int n = 0; n < 2; ++n) { const f32x4 xv = *(const f32x4*)(xin + off + bj * HALF + n * 16);
                        const f32x4 y = xv + gv[bj][n] * (acc[ai][bj][m][n] + bv[bj][n]);
                        *(f32x4*)(xout + off + bj * HALF + n * 16) = y;
                        s += (y[0] * y[0] + y[1] * y[1]) + (y[2] * y[2] + y[3] * y[3]);
                        const f32x4 z = y * gs[bj][n]; u32x2 w; w.x = cvtpk(z[0], z[1]); w.y = cvtpk(z[2], z[3]);
                        *(u32x2*)(xg + off + bj * HALF + n * 16) = w; }
                s += __shfl_xor(s, 16); s += __shfl_xor(s, 32);
                if (fq == 0) ssq[(size_t)row * 16 + u.pn * 4 + wc] = s; }
    }
};
struct EpiResidLast {
    static constexpr bool PERM = false;
    const float* xin; const float* gate; bf16_t* xb; float* ssq;
    __device__ __forceinline__ void operator()(const f32x4 (&acc)[2][2][4][2], const Unit& u, int wr, int wc, int fr, int fq, LAS float*, int) const {
        const int row0 = u.pm * BM + wr * 64 + fr, col0 = u.pn * BM + wc * 32 + 4 * fq;
        const float* gp = gate + (size_t)((u.pm * BM) >> 12) * 6144 + col0;
        f32x4 gv[2][2];
#pragma unroll
        for (int bj = 0; bj < 2; ++bj)
#pragma unroll
            for (int n = 0; n < 2; ++n) gv[bj][n] = *(const f32x4*)(gp + bj * HALF + n * 16);
#pragma unroll
        for (int ai = 0; ai < 2; ++ai)
#pragma unroll
            for (int m = 0; m < 4; ++m) { const int row = row0 + ai * HALF + m * 16; const size_t off = (size_t)row * DM + col0; float s = 0.f;
#pragma unroll
                for (int bj = 0; bj < 2; ++bj)
#pragma unroll
                    for (int n = 0; n < 2; ++n) { const f32x4 xv = *(const f32x4*)(xin + off + bj * HALF + n * 16);
                        const f32x4 y = xv + gv[bj][n] * acc[ai][bj][m][n];
                        s += (y[0] * y[0] + y[1] * y[1]) + (y[2] * y[2] + y[3] * y[3]);
                        u32x2 w; w.x = cvtpk(y[0], y[1]); w.y = cvtpk(y[2], y[3]);
                        *(u32x2*)(xb + off + bj * HALF + n * 16) = w; }
                s += __shfl_xor(s, 16); s += __shfl_xor(s, 32);
                if (fq == 0) ssq[(size_t)row * 16 + u.pn * 4 + wc] = s; }
    }
};
template <bool XIN_F32> struct EpiResB {
    static constexpr bool PERM = true;
    const void* xin; bf16_t* xout; const float* gate; const float* bias; bf16_t* xg; float* ssq; const float* gnext; const float* scale;
    __device__ __forceinline__ void operator()(const f32x4 (&acc)[2][2][4][2], const Unit& u, int wr, int wc, int fr, int fq, LAS float*, int) const {
        const int row0 = u.pm * BM + wr * 64 + fr, col0 = u.pn * BM + wc * 32 + 8 * fq, b = (u.pm * BM) >> 12;
        const float* gp = gate + (size_t)b * 6144 + col0;
        f32x4 gv[2][2], bv[2][2], gs[2][2];
#pragma unroll
        for (int bj = 0; bj < 2; ++bj)
#pragma unroll
            for (int n = 0; n < 2; ++n) { gv[bj][n] = *(const f32x4*)(gp + bj * HALF + n * 4); bv[bj][n] = bias ? *(const f32x4*)(bias + col0 + bj * HALF + n * 4) : (f32x4){0.f, 0.f, 0.f, 0.f};
                gs[bj][n] = xg ? *(const f32x4*)(gnext + col0 + bj * HALF + n * 4) * (*(const f32x4*)(scale + (size_t)b * 6144 + col0 + bj * HALF + n * 4) + 1.0f) : (f32x4){0.f, 0.f, 0.f, 0.f}; }
#pragma unroll
        for (int ai = 0; ai < 2; ++ai)
#pragma unroll
            for (int m = 0; m < 4; ++m) { const int row = row0 + ai * HALF + m * 16; const size_t off = (size_t)row * DM + col0; float s = 0.f;
#pragma unroll
                for (int bj = 0; bj < 2; ++bj) { f32x4 x0, x1;
                    if (XIN_F32) { const float* xp = (const float*)xin + off + bj * HALF; x0 = *(const f32x4*)xp; x1 = *(const f32x4*)(xp + 4); }
                    else { const u32x4 r = *(const u32x4*)((const bf16_t*)xin + off + bj * HALF);
                        x0 = (f32x4){__uint_as_float(r[0] << 16), __uint_as_float(r[0] & 0xffff0000u), __uint_as_float(r[1] << 16), __uint_as_float(r[1] & 0xffff0000u)};
                        x1 = (f32x4){__uint_as_float(r[2] << 16), __uint_as_float(r[2] & 0xffff0000u), __uint_as_float(r[3] << 16), __uint_as_float(r[3] & 0xffff0000u)}; }
                    const f32x4 y0 = x0 + gv[bj][0] * (acc[ai][bj][m][0] + bv[bj][0]), y1 = x1 + gv[bj][1] * (acc[ai][bj][m][1] + bv[bj][1]);
                    s += ((y0[0] * y0[0] + y0[1] * y0[1]) + (y0[2] * y0[2] + y0[3] * y0[3])) + ((y1[0] * y1[0] + y1[1] * y1[1]) + (y1[2] * y1[2] + y1[3] * y1[3]));
                    u32x4 w; w.x = cvtpk(y0[0], y0[1]); w.y = cvtpk(y0[2], y0[3]); w.z = cvtpk(y1[0], y1[1]); w.w = cvtpk(y1[2], y1[3]);
                    *(u32x4*)(xout + off + bj * HALF) = w;
                    if (xg) { const f32x4 z0 = y0 * gs[bj][0], z1 = y1 * gs[bj][1];
                        u32x4 v; v.x = cvtpk(z0[0], z0[1]); v.y = cvtpk(z0[2], z0[3]); v.z = cvtpk(z1[0], z1[1]); v.w = cvtpk(z1[2], z1[3]);
                        *(u32x4*)(xg + off + bj * HALF) = v; } }
                if (ssq) { s += __shfl_xor(s, 16); s += __shfl_xor(s, 32);
                    if (fq == 0) ssq[(size_t)row * 16 + u.pn * 4 + wc] = s; } }
    }
};
struct EpiFinal {
    static constexpr bool PERM = true;
    const bf16_t* xin; const float* gate; const float* gfin; float* out; float* exch; unsigned* cnt;
    __device__ __forceinline__ void operator()(const f32x4 (&acc)[2][2][4][2], const Unit& u, int wr, int wc, int fr, int fq, LAS float* xs, int) const {
        const int rl0 = wr * 64 + fr, col0 = u.pn * BM + wc * 32 + 8 * fq, b = (u.pm * BM) >> 12, t = threadIdx.x;
        const float* gp = gate + (size_t)b * 6144 + col0;
        f32x4 gv[2][2];
#pragma unroll
        for (int bj = 0; bj < 2; ++bj)
#pragma unroll
            for (int n = 0; n < 2; ++n) gv[bj][n] = *(const f32x4*)(gp + bj * HALF + n * 4);
        f32x4 y[2][4][2][2];
#pragma unroll
        for (int ai = 0; ai < 2; ++ai)
#pragma unroll
            for (int m = 0; m < 4; ++m) { const int rl = ai * HALF + rl0 + m * 16; const size_t off = (size_t)(u.pm * BM + rl) * DM + col0; float s = 0.f;
#pragma unroll
                for (int bj = 0; bj < 2; ++bj) { const u32x4 r = *(const u32x4*)(xin + off + bj * HALF);
                    const f32x4 x0 = (f32x4){__uint_as_float(r[0] << 16), __uint_as_float(r[0] & 0xffff0000u), __uint_as_float(r[1] << 16), __uint_as_float(r[1] & 0xffff0000u)};
                    const f32x4 x1 = (f32x4){__uint_as_float(r[2] << 16), __uint_as_float(r[2] & 0xffff0000u), __uint_as_float(r[3] << 16), __uint_as_float(r[3] & 0xffff0000u)};
                    const f32x4 y0 = x0 + gv[bj][0] * acc[ai][bj][m][0], y1 = x1 + gv[bj][1] * acc[ai][bj][m][1];
                    y[ai][m][bj][0] = y0; y[ai][m][bj][1] = y1;
                    s += ((y0[0] * y0[0] + y0[1] * y0[1]) + (y0[2] * y0[2] + y0[3] * y0[3])) + ((y1[0] * y1[0] + y1[1] * y1[1]) + (y1[2] * y1[2] + y1[3] * y1[3])); }
                s += __shfl_xor(s, 16); s += __shfl_xor(s, 32);
                if (fq == 0) xs[rl * 4 + wc] = s; }
        asm volatile("s_waitcnt lgkmcnt(0)" ::: "memory"); __builtin_amdgcn_s_barrier(); asm volatile("" ::: "memory");
        if (t < 256) { const f32x4 pr = *(const LAS f32x4*)(xs + t * 4);
            __hip_atomic_store(exch + ((size_t)u.pm * BM + t) * 4 + u.pn, (pr[0] + pr[1]) + (pr[2] + pr[3]), __ATOMIC_RELAXED, __HIP_MEMORY_SCOPE_AGENT); }
        asm volatile("s_waitcnt vmcnt(0)" ::: "memory"); __builtin_amdgcn_s_barrier(); asm volatile("" ::: "memory");
        if (t == 0) { unsigned* cp = cnt + u.pm * 4;
            __builtin_amdgcn_fence(__ATOMIC_RELEASE, "agent");
            (void)__hip_atomic_fetch_add(cp, 1u, __ATOMIC_RELAXED, __HIP_MEMORY_SCOPE_AGENT);
            unsigned sp = 0u;
            while (__hip_atomic_load(cp, __ATOMIC_RELAXED, __HIP_MEMORY_SCOPE_AGENT) < 4u) { __builtin_amdgcn_s_sleep(1); if (++sp > (1u << 22)) break; }
            __builtin_amdgcn_fence(__ATOMIC_ACQUIRE, "agent");
            asm volatile("s_waitcnt vmcnt(0)" ::: "memory"); }
        __builtin_amdgcn_s_barrier(); asm volatile("" ::: "memory");
        if (t < 256) { const float* ep = exch + ((size_t)u.pm * BM + t) * 4; float tot = 0.f;
#pragma unroll
            for (int q = 0; q < 4; ++q) tot += __hip_atomic_load(ep + q, __ATOMIC_RELAXED, __HIP_MEMORY_SCOPE_AGENT);
            xs[1024 + t] = __builtin_amdgcn_rsqf(tot * (1.0f / DM) + EPSN); }
        asm volatile("s_waitcnt lgkmcnt(0)" ::: "memory"); __builtin_amdgcn_s_barrier(); asm volatile("" ::: "memory");
        f32x4 gf[2][2];
#pragma unroll
        for (int bj = 0; bj < 2; ++bj)
#pragma unroll
            for (int n = 0; n < 2; ++n) gf[bj][n] = *(const f32x4*)(gfin + col0 + bj * HALF + n * 4);
#pragma unroll
        for (int ai = 0; ai < 2; ++ai)
#pragma unroll
            for (int m = 0; m < 4; ++m) { const int rl = ai * HALF + rl0 + m * 16; const float rs = xs[1024 + rl]; float* op = out + (size_t)(u.pm * BM + rl) * DM + col0;
#pragma unroll
                for (int bj = 0; bj < 2; ++bj) { *(f32x4*)(op + bj * HALF) = y[ai][m][bj][0] * rs * gf[bj][0]; *(f32x4*)(op + bj * HALF + 4) = y[ai][m][bj][1] * rs * gf[bj][1]; } }
    }
};
struct EpiSwiGLU2 {
    static constexpr bool PERM = true;
    bf16_t* act; const float* ssq; const float* shw;
    __device__ __forceinline__ void operator()(const f32x4 (&acc)[2][2][4][2], const Unit& u, int wr, int wc, int fr, int fq, LAS float* xs, int ui) const {
        xs += ui * 256;
        const int rl0 = wr * 64 + fr, row0 = u.pm * BM + rl0, col0 = u.pn * HALF + wc * 32 + 8 * fq, b = (u.pm * BM) >> 12;
        const LAS float* sw = xs + 3072 + wc * 32 + 8 * fq;
        const f32x4 sg0 = *(const LAS f32x4*)sw, sg1 = *(const LAS f32x4*)(sw + 4), su0 = *(const LAS f32x4*)(sw + HALF), su1 = *(const LAS f32x4*)(sw + HALF + 4);
#pragma unroll
        for (int ai = 0; ai < 2; ++ai)
#pragma unroll
            for (int m = 0; m < 4; ++m) { const float rs = xs[ai * HALF + rl0 + m * 16];
                const f32x4 g0 = acc[ai][0][m][0] * rs + sg0, g1 = acc[ai][0][m][1] * rs + sg1, u0 = acc[ai][1][m][0] * rs + su0, u1 = acc[ai][1][m][1] * rs + su1;
                u32x4 w; w.x = cvtpk(silu_f(g0[0]) * u0[0], silu_f(g0[1]) * u0[1]); w.y = cvtpk(silu_f(g0[2]) * u0[2], silu_f(g0[3]) * u0[3]);
                w.z = cvtpk(silu_f(g1[0]) * u1[0], silu_f(g1[1]) * u1[1]); w.w = cvtpk(silu_f(g1[2]) * u1[2], silu_f(g1[3]) * u1[3]);
                *(u32x4*)(act + (size_t)(row0 + ai * HALF + m * 16) * DFF + col0) = w; }
    }
};
struct EpiBf16 {
    static constexpr bool PERM = true;
    bf16_t* O;
    __device__ __forceinline__ void operator()(const f32x4 (&acc)[2][2][4][2], const Unit& u, int wr, int wc, int fr, int fq, LAS float*, int) const {
        const int row0 = u.pm * BM + wr * 64 + fr, col0 = u.pn * BM + wc * 32 + 8 * fq;
#pragma unroll
        for (int ai = 0; ai < 2; ++ai)
#pragma unroll
            for (int m = 0; m < 4; ++m) { bf16_t* rowp = O + (size_t)(row0 + ai * HALF + m * 16) * DM + col0;
#pragma unroll
                for (int bj = 0; bj < 2; ++bj) { const f32x4 v0 = acc[ai][bj][m][0], v1 = acc[ai][bj][m][1];
                    u32x4 w; w.x = cvtpk(v0[0], v0[1]); w.y = cvtpk(v0[2], v0[3]); w.z = cvtpk(v1[0], v1[1]); w.w = cvtpk(v1[2], v1[3]);
                    *(u32x4*)(rowp + bj * HALF) = w; } }
    }
};
struct EpiQKV {
    static constexpr bool PERM = true;
    bf16_t* Q; bf16_t* Kc; bf16_t* Vc; const float* gq; const float* gk; const float* rope;
    __device__ __forceinline__ void operator()(const f32x4 (&acc)[2][2][4][2], const Unit& u, int wr, int wc, int fr, int fq, LAS float* xs, int ui) const {
        const int rl0 = wr * 64 + fr, cl = wc * 32 + 8 * fq;
        if (u.pn == 5) {
#pragma unroll
            for (int ai = 0; ai < 2; ++ai)
#pragma unroll
                for (int m = 0; m < 4; ++m) { const int R = u.pm * BM + ai * HALF + rl0 + m * 16; int b, pos;
                    if (R < MTOK) { b = R >> 12; pos = R & 4095; } else { const int r2 = R - MTOK; b = r2 >> 8; pos = SEQ + (r2 & 255); }
#pragma unroll
                    for (int bj = 0; bj < 2; ++bj) { const f32x4 v0 = acc[ai][bj][m][0], v1 = acc[ai][bj][m][1];
                        u32x4 w; w.x = cvtpk(v0[0], v0[1]); w.y = cvtpk(v0[2], v0[3]); w.z = cvtpk(v1[0], v1[1]); w.w = cvtpk(v1[2], v1[3]);
                        *(u32x4*)(Vc + ((size_t)(b * NKVH + bj) * SKV + pos) * HD + cl) = w; } }
            return;
        }
        const bool isk = (u.pn == 4);
#pragma unroll
        for (int ai = 0; ai < 2; ++ai)
#pragma unroll
            for (int m = 0; m < 4; ++m)
#pragma unroll
                for (int bj = 0; bj < 2; ++bj) { const f32x4 v0 = acc[ai][bj][m][0], v1 = acc[ai][bj][m][1];
                    float s = (v0[0] * v0[0] + v0[1] * v0[1]) + (v0[2] * v0[2] + v0[3] * v0[3]) + (v1[0] * v1[0] + v1[1] * v1[1]) + (v1[2] * v1[2] + v1[3] * v1[3]);
                    s += __shfl_xor(s, 16); s += __shfl_xor(s, 32);
                    if (fq == 0) xs[((ai * HALF + rl0 + m * 16) * 2 + bj) * 4 + wc] = s; }
        asm volatile("s_waitcnt lgkmcnt(0)" ::: "memory"); __builtin_amdgcn_s_barrier(); asm volatile("" ::: "memory");
        const float* g = isk ? gk : gq;
        const int p0 = 16 * wc + 4 * fq;
        const f32x4 ga = *(const f32x4*)(g + p0), gb = *(const f32x4*)(g + 64 + p0);
#pragma unroll
        for (int ai = 0; ai < 2; ++ai)
#pragma unroll
            for (int m = 0; m < 4; ++m) { const int rl = ai * HALF + rl0 + m * 16, R = u.pm * BM + rl; int b, pos; bool isctx = false;
                if (R < MTOK) { b = R >> 12; pos = R & 4095; } else { const int r2 = R - MTOK; b = r2 >> 8; pos = SEQ + (r2 & 255); isctx = true; }
                f32x4 t0 = (f32x4){1.f, 0.f, 1.f, 0.f}, t1 = (f32x4){1.f, 0.f, 1.f, 0.f};
                if (!isctx) { const int pp = (wc < 2) ? (pos >> 6) : (pos & 63); const float* tp = rope + ((size_t)pp * 32 + (p0 & 31)) * 2;
                    t0 = *(const f32x4*)tp; t1 = *(const f32x4*)(tp + 4); }
#pragma unroll
                for (int bj = 0; bj < 2; ++bj) {
                    const f32x4 part = *(const LAS f32x4*)(xs + (rl * 2 + bj) * 4);
                    const float rstd = __builtin_amdgcn_rsqf(((part[0] + part[1]) + (part[2] + part[3])) * (1.0f / 128.0f) + EPSN);
                    const f32x4 v0 = acc[ai][bj][m][0], v1 = acc[ai][bj][m][1];
                    const float a0 = v0[0] * rstd * ga[0], b0 = v0[1] * rstd * gb[0], a1 = v0[2] * rstd * ga[1], b1 = v0[3] * rstd * gb[1];
                    const float a2 = v1[0] * rstd * ga[2], b2 = v1[1] * rstd * gb[2], a3 = v1[2] * rstd * ga[3], b3 = v1[3] * rstd * gb[3];
                    u32x4 w;
                    w.x = cvtpk(a0 * t0[0] - b0 * t0[1], a0 * t0[1] + b0 * t0[0]); w.y = cvtpk(a1 * t0[2] - b1 * t0[3], a1 * t0[3] + b1 * t0[2]);
                    w.z = cvtpk(a2 * t1[0] - b2 * t1[1], a2 * t1[1] + b2 * t1[0]); w.w = cvtpk(a3 * t1[2] - b3 * t1[3], a3 * t1[3] + b3 * t1[2]);
                    bf16_t* dst = isk ? (Kc + ((size_t)(b * NKVH + bj) * SKV + pos) * HD + cl) : (Q + (size_t)R * DM + (2 * u.pn + bj) * HD + cl);
                    *(u32x4*)dst = w; }
                __builtin_amdgcn_sched_barrier(0); }
    }
};

template <class Sched> __device__ __forceinline__ void rstd_prestep(const Sched& S, const float* __restrict__ ssq, const float* __restrict__ shw, LAS float* xs) {
    const int t = threadIdx.x, rowl = t >> 1, half = t & 1;
#pragma unroll 1
    for (int i = 0; i < 12; ++i) { Unit u; if (!S.next(i, u)) break;
        const float* pp = ssq + (size_t)(u.pm * BM + rowl) * 16 + half * 8;
        const f32x4 a = *(const f32x4*)pp, c = *(const f32x4*)(pp + 4); float s = ((a[0] + a[1]) + (a[2] + a[3])) + ((c[0] + c[1]) + (c[2] + c[3]));
        s += __shfl_xor(s, 1);
        if (half == 0) xs[i * 256 + rowl] = __builtin_amdgcn_rsqf(s * (1.0f / DM) + EPSN);
        if (t < 256) xs[3072 + i * 256 + t] = shw[(size_t)((u.pm * BM) >> 12) * (2 * DFF) + u.pn * BM + t]; }
    __syncthreads();
}
constexpr int NW = 8, QBLK = 32, KVBLK = 64;
constexpr float SCALE = 0.088388347648318440f, THR = 8.f;
constexpr int LDQ = DM, LDK = HD, LDO = DM;
constexpr size_t SHM_V = KVBLK * HD * 2, SHM_K = KVBLK * HD * 2, SHM_ATTN = 2 * SHM_V + 2 * SHM_K + NW * 64 * 4;
#define KSWZ(row, colB) ((row) * 256 + ((colB) ^ (((row) & 7) << 4)))
#define SBAR() __builtin_amdgcn_sched_barrier(0)
__device__ __forceinline__ int crow(int r, int hi) { return (r & 3) + 8 * (r >> 2) + 4 * hi; }
__device__ __forceinline__ void partialSM(f32x16& p0, f32x16& p1, float mnC) {
  constexpr float C = SCALE * 1.4426950408889634f;
  for (int r = 0; r < 16; ++r) p0[r] = fmaf(p0[r], C, mnC); for (int r = 0; r < 16; ++r) p1[r] = fmaf(p1[r], C, mnC);
  for (int r = 0; r < 16; ++r) p0[r] = __builtin_amdgcn_exp2f(p0[r]);
}
__device__ __forceinline__ void finishSM(f32x16& p0, f32x16& p1, float& l_reg, bf16x8& pa0, bf16x8& pa1, bf16x8& pa2, bf16x8& pa3) {
  for (int r = 0; r < 16; ++r) p1[r] = __builtin_amdgcn_exp2f(p1[r]);
  float ps = 0; for (int r = 0; r < 16; ++r) ps += p0[r]; for (int r = 0; r < 16; ++r) ps += p1[r];
  { auto rr = __builtin_amdgcn_permlane32_swap(__float_as_uint(ps), __float_as_uint(ps), false, false);
    ps = __uint_as_float(rr[0]) + __uint_as_float(rr[1]); }
  l_reg += ps;
#define PK4(P, BASE, OUT) do { unsigned a0 = cvtpk(P[BASE + 0], P[BASE + 1]), a1 = cvtpk(P[BASE + 2], P[BASE + 3]);   \
    unsigned b0 = cvtpk(P[BASE + 4], P[BASE + 5]), b1 = cvtpk(P[BASE + 6], P[BASE + 7]);                              \
    auto r0 = __builtin_amdgcn_permlane32_swap(a0, b0, false, false); auto r1 = __builtin_amdgcn_permlane32_swap(a1, b1, false, false); \
    u32x4 w = {r0[0], r1[0], r0[1], r1[1]}; OUT = *reinterpret_cast<bf16x8*>(&w); } while (0)
  PK4(p0, 0, pa0); PK4(p0, 8, pa1); PK4(p1, 0, pa2); PK4(p1, 8, pa3);
#undef PK4
}
__device__ __forceinline__ void qkt(f32x16& p0, f32x16& p1, const bf16_t* Ks, const bf16x8* qr, int r32, int hi) {
  p0 = f32x16{}; p1 = f32x16{};
  const char* kp = (const char*)Ks;
#pragma unroll
  for (int h = 0; h < 2; ++h) {
    bf16x8 b0[4], b1[4];
#pragma unroll
    for (int q = 0; q < 4; ++q) { const int cb = ((h * 4 + q) * 16 + hi * 8) * 2;
      b0[q] = *reinterpret_cast<const bf16x8*>(kp + KSWZ(r32, cb)); b1[q] = *reinterpret_cast<const bf16x8*>(kp + KSWZ(32 + r32, cb)); }
    __builtin_amdgcn_sched_barrier(0x6);
#pragma unroll
    for (int q = 0; q < 4; ++q) {
      p0 = __builtin_amdgcn_mfma_f32_32x32x16_bf16(b0[q], qr[h * 4 + q], p0, 0, 0, 0);
      p1 = __builtin_amdgcn_mfma_f32_32x32x16_bf16(b1[q], qr[h * 4 + q], p1, 0, 0, 0); }
    __builtin_amdgcn_sched_barrier(0x6);
  }
}
__device__ __forceinline__ int v_st(int k, int c) { const int kk = (k & ~0xC) | ((k & 4) << 1) | ((k & 8) >> 1); return ((kk >> 3) * 4 + (c >> 5)) * 512 + ((kk & 7) * 32 + (c & 31)) * 2; }
__device__ __forceinline__ int v_rd_base(int lane) { return ((lane & 3) << 3) | (((lane >> 2) & 3) << 6) | (((lane >> 4) & 1) << 5) | (((lane >> 5) & 1) << 8); }
constexpr int v_rd_off(int d0, int ks, int half) { return d0 * 512 + ks * 4096 + half * 2048; }
template <int OFF> __device__ __forceinline__ s16x4 tr_read(int vb) {
  s16x4 r; asm volatile("ds_read_b64_tr_b16 %0, %1 offset:%2" : "=&v"(r) : "v"(vb), "i"(OFF) : "memory"); return r;
}
template <int D0> __device__ __forceinline__ void pv_one(f32x16& od, int vb, bf16x8 pa0, bf16x8 pa1, bf16x8 pa2, bf16x8 pa3) {
  const s16x4 l0 = tr_read<v_rd_off(D0, 0, 0)>(vb), h0 = tr_read<v_rd_off(D0, 0, 1)>(vb), l1 = tr_read<v_rd_off(D0, 1, 0)>(vb), h1 = tr_read<v_rd_off(D0, 1, 1)>(vb);
  const s16x4 l2 = tr_read<v_rd_off(D0, 2, 0)>(vb), h2 = tr_read<v_rd_off(D0, 2, 1)>(vb), l3 = tr_read<v_rd_off(D0, 3, 0)>(vb), h3 = tr_read<v_rd_off(D0, 3, 1)>(vb);
  asm volatile("s_waitcnt lgkmcnt(0)" ::: "memory"); SBAR();
#define PK(L, H) (bf16x8){L[0], L[1], L[2], L[3], H[0], H[1], H[2], H[3]}
  od = __builtin_amdgcn_mfma_f32_32x32x16_bf16(pa0, PK(l0, h0), od, 0, 0, 0);
  od = __builtin_amdgcn_mfma_f32_32x32x16_bf16(pa1, PK(l1, h1), od, 0, 0, 0);
  od = __builtin_amdgcn_mfma_f32_32x32x16_bf16(pa2, PK(l2, h2), od, 0, 0, 0);
  od = __builtin_amdgcn_mfma_f32_32x32x16_bf16(pa3, PK(l3, h3), od, 0, 0, 0);
#undef PK
}
__device__ __forceinline__ void pv_d0(f32x16* o, int vb, bf16x8 pa0, bf16x8 pa1, bf16x8 pa2, bf16x8 pa3) {
  pv_one<0>(o[0], vb, pa0, pa1, pa2, pa3); pv_one<1>(o[1], vb, pa0, pa1, pa2, pa3); pv_one<2>(o[2], vb, pa0, pa1, pa2, pa3); pv_one<3>(o[3], vb, pa0, pa1, pa2, pa3);
}
__device__ __forceinline__ void attn_dense_body(const bf16_t* __restrict__ Qb, const bf16_t* __restrict__ Kh, const bf16_t* __restrict__ Vh,
                                                bf16_t* __restrict__ Ob, int seq, char* lds, LAS unsigned char* ldsl, float mnC) {
  const int tid = threadIdx.x, wid = __builtin_amdgcn_readfirstlane(tid >> 6), lane = tid & 63, r32 = lane & 31, hi = lane >> 5;
  constexpr int SLOT = 32768;
  float* ws = (float*)(lds + 3 * SLOT) + wid * 64; float* li_l = ws;
  float l_reg = 0; f32x16 o[4] = {}; bf16x8 qr[8];
  unsigned voffK[2], voffV[2];
#pragma unroll
  for (int i = 0; i < 2; ++i) { const int P16 = i * 512 + tid;
    { const int row = P16 >> 4, g = (P16 & 15) ^ (row & 7); voffK[i] = (unsigned)(row * LDK + g * 8) * 2u; }
    { const int sub = P16 >> 5, kk = (sub >> 2) * 8 + ((P16 >> 2) & 7), c = (sub & 3) * 32 + (P16 & 3) * 8, k = (kk & ~0xC) | ((kk & 4) << 1) | ((kk & 8) >> 1);
      voffV[i] = (unsigned)(k * LDK + c) * 2u; } }
#define ADMA(jt, b) do { const char* _gk = (const char*)Kh + (size_t)(jt) * (KVBLK * LDK * 2); const char* _gv = (const char*)Vh + (size_t)(jt) * (KVBLK * LDK * 2); \
    _Pragma("unroll") for (int _i = 0; _i < 2; ++_i) { \
      __builtin_amdgcn_global_load_lds((const unsigned*)(_gv + voffV[_i]), (LAS unsigned*)(ldsl + (b) * SLOT + wid * 1024 + _i * 8192), 16, 0, 0); \
      __builtin_amdgcn_global_load_lds((const unsigned*)(_gk + voffK[_i]), (LAS unsigned*)(ldsl + (b) * SLOT + 16384 + wid * 1024 + _i * 8192), 16, 0, 0); } } while (0)
#define KBUF(b) ((const bf16_t*)(lds + (b) * SLOT + 16384))
  const int NT = seq / KVBLK;
  ADMA(0, 0); ADMA(1, 1);
  const bf16_t* Qw = Qb + (long)(wid * QBLK + r32) * LDQ + hi * 8;
#pragma unroll
  for (int d0 = 0; d0 < 8; ++d0) qr[d0] = *reinterpret_cast<const bf16x8*>(Qw + d0 * 16);
  const int vb0 = (int)(uintptr_t)lds + v_rd_base(lane);
  f32x16 pA0, pA1, pB0, pB1; bf16x8 pa0, pa1, pa2, pa3;
  asm volatile("s_waitcnt vmcnt(0)" ::: "memory"); __syncthreads();
  qkt(pA0, pA1, KBUF(0), qr, r32, hi); partialSM(pA0, pA1, mnC);
  int bv = 0, bk = 1, bn = 2;
  for (int j = 1; j + 1 < NT; j += 2) {
    ADMA(j + 1, bn);
    SBAR(); qkt(pB0, pB1, KBUF(bk), qr, r32, hi);
    finishSM(pA0, pA1, l_reg, pa0, pa1, pa2, pa3); SBAR();
    pv_d0(o, vb0 + bv * SLOT, pa0, pa1, pa2, pa3); partialSM(pB0, pB1, mnC);
    asm volatile("s_waitcnt vmcnt(0)" ::: "memory"); __syncthreads();
    { const int t_ = bv; bv = bk; bk = bn; bn = t_; }
    if (j + 2 < NT) ADMA(j + 2, bn);
    SBAR(); qkt(pA0, pA1, KBUF(bk), qr, r32, hi);
    finishSM(pB0, pB1, l_reg, pa0, pa1, pa2, pa3); SBAR();
    pv_d0(o, vb0 + bv * SLOT, pa0, pa1, pa2, pa3); partialSM(pA0, pA1, mnC);
    asm volatile("s_waitcnt vmcnt(0)" ::: "memory"); __syncthreads();
    { const int t_ = bv; bv = bk; bk = bn; bn = t_; }
  }
  SBAR(); qkt(pB0, pB1, KBUF(bk), qr, r32, hi);
  finishSM(pA0, pA1, l_reg, pa0, pa1, pa2, pa3); SBAR();
  pv_d0(o, vb0 + bv * SLOT, pa0, pa1, pa2, pa3); partialSM(pB0, pB1, mnC);
  finishSM(pB0, pB1, l_reg, pa0, pa1, pa2, pa3); SBAR();
  pv_d0(o, vb0 + bk * SLOT, pa0, pa1, pa2, pa3);
  if (hi == 0) li_l[r32] = l_reg; asm volatile("s_waitcnt lgkmcnt(0)" ::: "memory");
  float rli[16];
#pragma unroll
  for (int r = 0; r < 16; ++r) rli[r] = __builtin_amdgcn_rcpf(li_l[crow(r, hi)]);
  bf16_t* Ow = Ob + (long)(wid * QBLK) * LDO;
#pragma unroll
  for (int r = 0; r < 16; ++r) { int orow = crow(r, hi);
    for (int d0 = 0; d0 < 4; ++d0) Ow[(long)orow * LDO + d0 * 32 + r32] = (bf16_t)(cvtpk(o[d0][r] * rli[r], 0.f) & 0xffffu); }
#undef ADMA
#undef KBUF
}

__device__ __forceinline__ void phase_fft1(const bf16_t* __restrict__ Xb, const float* __restrict__ ssq, const float* __restrict__ gmix, const float* __restrict__ modl,
                                           bf16_t* __restrict__ AP, char* lds) {
    const int tid = threadIdx.x, wid = tid >> 6, lane = tid & 63, r32 = lane & 31, hi = lane >> 5, kb = wid & 3, dh = wid >> 2, G = gridDim.x;
    float* tab = (float*)(lds + 65536);
    float* rs = (float*)(lds + 81920);
    for (int i = tid; i < 4096; i += 512) tab[i] = __builtin_amdgcn_cosf((float)i * (1.0f / 4096.0f));
    for (int idx = tid; idx < 1024; idx += 512) { const int i = idx >> 6, n1 = idx & 63, t = blockIdx.x + G * i;
        if (t < 4096) { const float* pp = ssq + (size_t)((t >> 9) * SEQ + 64 * n1 + ((t >> 3) & 63)) * 16;
            const f32x4 a = *(const f32x4*)pp, b = *(const f32x4*)(pp + 4), c = *(const f32x4*)(pp + 8), d = *(const f32x4*)(pp + 12);
            const float s = (((a[0] + a[1]) + (a[2] + a[3])) + ((b[0] + b[1]) + (b[2] + b[3]))) + (((c[0] + c[1]) + (c[2] + c[3])) + ((d[0] + d[1]) + (d[2] + d[3])));
            rs[idx] = __builtin_amdgcn_rsqf(s * (1.0f / DM) + EPSN); } }
    __syncthreads();
    bf16x8 pa[4];
    { const int k1 = 16 * kb + (r32 & 15), isim = r32 >> 4;
#pragma unroll
      for (int j = 0; j < 4; ++j) { u32x4 w; unsigned ww[4];
#pragma unroll
        for (int e2 = 0; e2 < 4; ++e2) { float v[2];
#pragma unroll
          for (int q = 0; q < 2; ++q) { const int n1 = 16 * j + 8 * hi + 2 * e2 + q, m = ((k1 * n1) & 63) * 64; v[q] = tab[isim ? ((m + 1024) & 4095) : m] * 0.125f; }
          ww[e2] = cvtpk(v[0], v[1]); }
        w.x = ww[0]; w.y = ww[1]; w.z = ww[2]; w.w = ww[3]; pa[j] = *reinterpret_cast<bf16x8*>(&w); } }
    const int sr = tid >> 4, sc = (tid & 15) * 8, vst0 = v_st(sr, sc), vst1 = v_st(32 + sr, sc);
    const int vb0 = (int)(uintptr_t)lds + v_rd_base(lane) + dh * 1024;
    u32x4 s0, s1; f32x4 pg0, pg1, psh0, psh1, psc0, psc1;
#define F1_SRC(t, n1) (Xb + ((size_t)(((t) >> 9) * SEQ + 64 * (n1) + (((t) >> 3) & 63))) * DM + ((t) & 7) * 128 + sc)
#define F1_LOAD(t) do { s0 = *reinterpret_cast<const u32x4*>(F1_SRC(t, sr)); s1 = *reinterpret_cast<const u32x4*>(F1_SRC(t, 32 + sr)); \
        const int ch0 = ((t) & 7) * 128 + sc; const float* mp = modl + (size_t)((t) >> 9) * 6144 + ch0; \
        pg0 = *(const f32x4*)(gmix + ch0); pg1 = *(const f32x4*)(gmix + ch0 + 4); psh0 = *(const f32x4*)mp; psh1 = *(const f32x4*)(mp + 4); \
        psc0 = *(const f32x4*)(mp + 1024) + 1.0f; psc1 = *(const f32x4*)(mp + 1028) + 1.0f; } while (0)
#define F1_NORM(S, R) ({ const f32x4 x0 = (f32x4){__uint_as_float(S[0] << 16), __uint_as_float(S[0] & 0xffff0000u), __uint_as_float(S[1] << 16), __uint_as_float(S[1] & 0xffff0000u)}; \
        const f32x4 x1 = (f32x4){__uint_as_float(S[2] << 16), __uint_as_float(S[2] & 0xffff0000u), __uint_as_float(S[3] << 16), __uint_as_float(S[3] & 0xffff0000u)}; \
        const f32x4 y0 = (x0 * (R) * pg0) * psc0 + psh0, y1 = (x1 * (R) * pg1) * psc1 + psh1; \
        u32x4 w; w.x = cvtpk(y0[0], y0[1]); w.y = cvtpk(y0[2], y0[3]); w.z = cvtpk(y1[0], y1[1]); w.w = cvtpk(y1[2], y1[3]); w; })
    int t = blockIdx.x, buf = 0, it = 0;
    if (t < 4096) F1_LOAD(t);
    for (; t < 4096; t += G, ++it) {
        { const float r0 = rs[it * 64 + sr], r1 = rs[it * 64 + 32 + sr];
          const u32x4 w0 = F1_NORM(s0, r0), w1 = F1_NORM(s1, r1);
          *(u32x4*)(lds + buf * 16384 + vst0) = w0; *(u32x4*)(lds + buf * 16384 + vst1) = w1; }
        __syncthreads();
        const int tn = t + G;
        if (tn < 4096) F1_LOAD(tn);
        if (kb < 3) {
        f32x16 o0 = {}, o1 = {};
        const int vb = vb0 + buf * 16384;
        pv_one<0>(o0, vb, pa[0], pa[1], pa[2], pa[3]); pv_one<1>(o1, vb, pa[0], pa[1], pa[2], pa[3]);
        const int b = t >> 9, n2 = (t >> 3) & 63, chblk = t & 7;
#pragma unroll
        for (int r = 0; r < 8; ++r) { const int k1 = 16 * kb + crow(r, hi), m = (k1 * n2) & 4095; const float cw = tab[m], sw = tab[(m + 1024) & 4095];
            bf16_t* dst = AP + ((((size_t)b * 64 + k1) * 2) * 64 + n2) * DM + chblk * 128 + dh * 64 + r32;
            const float re0 = o0[r], im0 = o0[r + 8], re1 = o1[r], im1 = o1[r + 8];
            if (k1 <= 32) {
            dst[0] = (bf16_t)(cvtpk(re0 * cw - im0 * sw, 0.f) & 0xffffu); dst[32] = (bf16_t)(cvtpk(re1 * cw - im1 * sw, 0.f) & 0xffffu);
            dst[65536] = (bf16_t)(cvtpk(re0 * sw + im0 * cw, 0.f) & 0xffffu); dst[65536 + 32] = (bf16_t)(cvtpk(re1 * sw + im1 * cw, 0.f) & 0xffffu); } }
        }
        buf ^= 1;
    }
#undef F1_SRC
#undef F1_LOAD
#undef F1_NORM
    __syncthreads();
}
__device__ __forceinline__ void phase_fft3(const bf16_t* __restrict__ AP, bf16_t* __restrict__ Z, char* lds) {
    const int tid = threadIdx.x, wid = tid >> 6, lane = tid & 63, r32 = lane & 31, hi = lane >> 5, kb = wid & 3, dh = wid >> 2, G = gridDim.x;
    float* tab = (float*)(lds + 65536);
    for (int i = tid; i < 4096; i += 512) tab[i] = __builtin_amdgcn_cosf((float)i * (1.0f / 4096.0f));
    __syncthreads();
    bf16x8 pa[8];
    { const int k2 = 16 * kb + (r32 & 15), ri = r32 >> 4;
#pragma unroll
      for (int j = 0; j < 8; ++j) { u32x4 w; unsigned ww[4];
#pragma unroll
        for (int e2 = 0; e2 < 4; ++e2) { float v[2];
#pragma unroll
          for (int q = 0; q < 2; ++q) { const int kap = 16 * j + 8 * hi + 2 * e2 + q, rip = kap >> 6, n2 = kap & 63, m = ((k2 * n2) & 63) * 64;
              const int id = (ri == rip) ? m : (ri == 0 ? ((m - 1024) & 4095) : ((m + 1024) & 4095));
              v[q] = tab[id] * 0.125f; }
          ww[e2] = cvtpk(v[0], v[1]); }
        w.x = ww[0]; w.y = ww[1]; w.z = ww[2]; w.w = ww[3]; pa[j] = *reinterpret_cast<bf16x8*>(&w); } }
    const int sr = tid >> 4, sc = (tid & 15) * 8, vst0 = v_st(sr, sc), vst1 = v_st(32 + sr, sc);
    const int vb0 = (int)(uintptr_t)lds + v_rd_base(lane) + dh * 1024;
    bf16x8 s0, s1, s2, s3;
    constexpr int NT3 = NBATCH * 33 * 8;
#define T3_IDX(tp) ((((tp) >> 3) / 33) * 64 + (((tp) >> 3) % 33))
#define F3_SRC(tp, rip, n2) (AP + (((size_t)T3_IDX(tp) * 2 + (rip)) * 64 + (n2)) * DM + ((tp) & 7) * 128 + sc)
    int t = blockIdx.x, buf = 0;
    if (t < NT3) { s0 = *reinterpret_cast<const bf16x8*>(F3_SRC(t, 0, sr)); s1 = *reinterpret_cast<const bf16x8*>(F3_SRC(t, 0, 32 + sr));
                   s2 = *reinterpret_cast<const bf16x8*>(F3_SRC(t, 1, sr)); s3 = *reinterpret_cast<const bf16x8*>(F3_SRC(t, 1, 32 + sr)); }
    for (; t < NT3; t += G) {
        char* lb = lds + buf * 32768;
        *(bf16x8*)(lb + vst0) = s0; *(bf16x8*)(lb + vst1) = s1; *(bf16x8*)(lb + 16384 + vst0) = s2; *(bf16x8*)(lb + 16384 + vst1) = s3;
        __syncthreads();
        const int tn = t + G;
        if (tn < NT3) { s0 = *reinterpret_cast<const bf16x8*>(F3_SRC(tn, 0, sr)); s1 = *reinterpret_cast<const bf16x8*>(F3_SRC(tn, 0, 32 + sr));
                        s2 = *reinterpret_cast<const bf16x8*>(F3_SRC(tn, 1, sr)); s3 = *reinterpret_cast<const bf16x8*>(F3_SRC(tn, 1, 32 + sr)); }
        f32x16 o0 = {}, o1 = {};
        const int vb = vb0 + buf * 32768;
        pv_one<0>(o0, vb, pa[0], pa[1], pa[2], pa[3]); pv_one<1>(o1, vb, pa[0], pa[1], pa[2], pa[3]);
        pv_one<0>(o0, vb + 16384, pa[4], pa[5], pa[6], pa[7]); pv_one<1>(o1, vb + 16384, pa[4], pa[5], pa[6], pa[7]);
        const int idx = T3_IDX(t), b = idx >> 6, k1 = idx & 63, ch = (t & 7) * 128 + dh * 64 + r32, g = ch >> 8, cw = ch & 255;
        const bool mir = (k1 >= 1) && (k1 <= 31);
#pragma unroll
        for (int r = 0; r < 8; ++r) { const int k2 = 16 * kb + crow(r, hi);
            const unsigned re0 = cvtpk(o0[r], 0.f) & 0xffffu, re1 = cvtpk(o1[r], 0.f) & 0xffffu;
            bf16_t* dst = Z + ((size_t)(b * SEQ + k1 + 64 * k2)) * 2048 + g * 512 + cw;
            dst[0] = (bf16_t)re0; dst[32] = (bf16_t)re1;
            dst[256] = (bf16_t)(cvtpk(o0[r + 8], 0.f) & 0xffffu); dst[256 + 32] = (bf16_t)(cvtpk(o1[r + 8], 0.f) & 0xffffu);
            if (mir) { bf16_t* dm = Z + ((size_t)(b * SEQ + (64 - k1) + 64 * (63 - k2))) * 2048 + g * 512 + cw;
                dm[0] = (bf16_t)re0; dm[32] = (bf16_t)re1;
                dm[256] = (bf16_t)(cvtpk(-o0[r + 8], 0.f) & 0xffffu); dm[256 + 32] = (bf16_t)(cvtpk(-o1[r + 8], 0.f) & 0xffffu); } }
        buf ^= 1;
    }
#undef T3_IDX
#undef F3_SRC
    __syncthreads();
}

__device__ __forceinline__ float wave_sum(float s) {
    s += __shfl_xor(s, 1); s += __shfl_xor(s, 2); s += __shfl_xor(s, 4); s += __shfl_xor(s, 8); s += __shfl_xor(s, 16); s += __shfl_xor(s, 32); return s;
}
__device__ __forceinline__ void normmod_rows(const float* __restrict__ src, bf16_t* __restrict__ dst, const float* __restrict__ g, const float* __restrict__ modl,
                                             int jshift, int nrows, int bshift, int brow0) {
    const int lane = threadIdx.x & 63, gw = blockIdx.x * 8 + (threadIdx.x >> 6), nw = gridDim.x * 8;
    f32x4 gv[4];
#pragma unroll
    for (int i = 0; i < 4; ++i) gv[i] = *(const f32x4*)(g + lane * 4 + 256 * i);
    for (int row = gw; row < nrows; row += 2 * nw) {
        const int row2 = row + nw; const bool has2 = row2 < nrows;
        const float* x0 = src + (size_t)row * DM + lane * 4; const float* x1 = src + (size_t)(has2 ? row2 : row) * DM + lane * 4;
        f32x4 v0[4], v1[4];
#pragma unroll
        for (int i = 0; i < 4; ++i) { v0[i] = *(const f32x4*)(x0 + 256 * i); v1[i] = *(const f32x4*)(x1 + 256 * i); }
        float s0 = 0.f, s1 = 0.f;
#pragma unroll
        for (int i = 0; i < 4; ++i) { s0 += (v0[i][0] * v0[i][0] + v0[i][1] * v0[i][1]) + (v0[i][2] * v0[i][2] + v0[i][3] * v0[i][3]);
                                      s1 += (v1[i][0] * v1[i][0] + v1[i][1] * v1[i][1]) + (v1[i][2] * v1[i][2] + v1[i][3] * v1[i][3]); }
        s0 = wave_sum(s0); s1 = wave_sum(s1);
        const float r0 = __builtin_amdgcn_rsqf(s0 * (1.0f / DM) + EPSN), r1 = __builtin_amdgcn_rsqf(s1 * (1.0f / DM) + EPSN);
        const float* m0 = modl + (size_t)(brow0 + (row >> bshift)) * 6144 + jshift * 1024 + lane * 4;
        const float* m1 = modl + (size_t)(brow0 + ((has2 ? row2 : row) >> bshift)) * 6144 + jshift * 1024 + lane * 4;
#pragma unroll
        for (int i = 0; i < 4; ++i) {
            const f32x4 sh0 = *(const f32x4*)(m0 + 256 * i), sc0 = *(const f32x4*)(m0 + 1024 + 256 * i);
            const f32x4 y0 = (v0[i] * r0 * gv[i]) * (sc0 + 1.0f) + sh0;
            u32x2 w0; w0.x = cvtpk(y0[0], y0[1]); w0.y = cvtpk(y0[2], y0[3]);
            *(u32x2*)(dst + (size_t)row * DM + lane * 4 + 256 * i) = w0;
            if (has2) { const f32x4 sh1 = *(const f32x4*)(m1 + 256 * i), sc1 = *(const f32x4*)(m1 + 1024 + 256 * i);
                const f32x4 y1 = (v1[i] * r1 * gv[i]) * (sc1 + 1.0f) + sh1;
                u32x2 w1; w1.x = cvtpk(y1[0], y1[1]); w1.y = cvtpk(y1[2], y1[3]);
                *(u32x2*)(dst + (size_t)row2 * DM + lane * 4 + 256 * i) = w1; }
        }
    }
}
__device__ __forceinline__ void final_norm(const float* __restrict__ src, float* __restrict__ dst, const float* __restrict__ g) {
    const int lane = threadIdx.x & 63, gw = blockIdx.x * 8 + (threadIdx.x >> 6), nw = gridDim.x * 8;
    f32x4 gv[4];
#pragma unroll
    for (int i = 0; i < 4; ++i) gv[i] = *(const f32x4*)(g + lane * 4 + 256 * i);
    for (int row = gw; row < MTOK; row += 2 * nw) {
        const int row2 = row + nw; const bool has2 = row2 < MTOK;
        const float* x0 = src + (size_t)row * DM + lane * 4; const float* x1 = src + (size_t)(has2 ? row2 : row) * DM + lane * 4;
        f32x4 v0[4], v1[4];
#pragma unroll
        for (int i = 0; i < 4; ++i) { v0[i] = *(const f32x4*)(x0 + 256 * i); v1[i] = *(const f32x4*)(x1 + 256 * i); }
        float s0 = 0.f, s1 = 0.f;
#pragma unroll
        for (int i = 0; i < 4; ++i) { s0 += (v0[i][0] * v0[i][0] + v0[i][1] * v0[i][1]) + (v0[i][2] * v0[i][2] + v0[i][3] * v0[i][3]);
                                      s1 += (v1[i][0] * v1[i][0] + v1[i][1] * v1[i][1]) + (v1[i][2] * v1[i][2] + v1[i][3] * v1[i][3]); }
        s0 = wave_sum(s0); s1 = wave_sum(s1);
        const float r0 = __builtin_amdgcn_rsqf(s0 * (1.0f / DM) + EPSN), r1 = __builtin_amdgcn_rsqf(s1 * (1.0f / DM) + EPSN);
#pragma unroll
        for (int i = 0; i < 4; ++i) { *(f32x4*)(dst + (size_t)row * DM + lane * 4 + 256 * i) = v0[i] * r0 * gv[i];
            if (has2) *(f32x4*)(dst + (size_t)row2 * DM + lane * 4 + 256 * i) = v1[i] * r1 * gv[i]; }
    }
}

__device__ __forceinline__ void normmod_rows_b(const bf16_t* __restrict__ src, bf16_t* __restrict__ dst, const float* __restrict__ g, const float* __restrict__ modl, int jshift, int nrows) {
    const int lane = threadIdx.x & 63, gw = blockIdx.x * 8 + (threadIdx.x >> 6), nw = gridDim.x * 8;
    f32x4 gv[4];
    gv[0] = *(const f32x4*)(g + lane * 8); gv[1] = *(const f32x4*)(g + lane * 8 + 4); gv[2] = *(const f32x4*)(g + 512 + lane * 8); gv[3] = *(const f32x4*)(g + 512 + lane * 8 + 4);
    for (int row = gw; row < nrows; row += nw) {
        const u32x4 a0 = *(const u32x4*)(src + (size_t)row * DM + lane * 8), a1 = *(const u32x4*)(src + (size_t)row * DM + 512 + lane * 8);
        f32x4 v[4];
        v[0] = (f32x4){__uint_as_float(a0[0] << 16), __uint_as_float(a0[0] & 0xffff0000u), __uint_as_float(a0[1] << 16), __uint_as_float(a0[1] & 0xffff0000u)};
        v[1] = (f32x4){__uint_as_float(a0[2] << 16), __uint_as_float(a0[2] & 0xffff0000u), __uint_as_float(a0[3] << 16), __uint_as_float(a0[3] & 0xffff0000u)};
        v[2] = (f32x4){__uint_as_float(a1[0] << 16), __uint_as_float(a1[0] & 0xffff0000u), __uint_as_float(a1[1] << 16), __uint_as_float(a1[1] & 0xffff0000u)};
        v[3] = (f32x4){__uint_as_float(a1[2] << 16), __uint_as_float(a1[2] & 0xffff0000u), __uint_as_float(a1[3] << 16), __uint_as_float(a1[3] & 0xffff0000u)};
        float s = 0.f;
#pragma unroll
        for (int i = 0; i < 4; ++i) s += (v[i][0] * v[i][0] + v[i][1] * v[i][1]) + (v[i][2] * v[i][2] + v[i][3] * v[i][3]);
        s = wave_sum(s);
        const float r = __builtin_amdgcn_rsqf(s * (1.0f / DM) + EPSN);
        const float* m0 = modl + (size_t)(row >> 12) * 6144 + jshift * 1024;
        u32x4 w[2];
#pragma unroll
        for (int i = 0; i < 4; ++i) { const int c = (i >> 1) * 512 + lane * 8 + (i & 1) * 4;
            const f32x4 sh = *(const f32x4*)(m0 + c), sc = *(const f32x4*)(m0 + 1024 + c);
            const f32x4 y = (v[i] * r * gv[i]) * (sc + 1.0f) + sh;
            w[i >> 1][(i & 1) * 2] = cvtpk(y[0], y[1]); w[i >> 1][(i & 1) * 2 + 1] = cvtpk(y[2], y[3]); }
        *(u32x4*)(dst + (size_t)row * DM + lane * 8) = w[0]; *(u32x4*)(dst + (size_t)row * DM + 512 + lane * 8) = w[1];
    }
}
__device__ __forceinline__ void final_norm_bf16(const bf16_t* __restrict__ xb, const float* __restrict__ ssq, float* __restrict__ dst, const float* __restrict__ g) {
    const int lane = threadIdx.x & 63, gw = blockIdx.x * 8 + (threadIdx.x >> 6), nw = gridDim.x * 8;
    f32x4 gv[4];
    gv[0] = *(const f32x4*)(g + lane * 8); gv[1] = *(const f32x4*)(g + lane * 8 + 4); gv[2] = *(const f32x4*)(g + 512 + lane * 8); gv[3] = *(const f32x4*)(g + 512 + lane * 8 + 4);
    for (int row = gw; row < MTOK; row += 2 * nw) {
        const int row2 = (row + nw < MTOK) ? row + nw : row;
        const u32x4 a0 = *(const u32x4*)(xb + (size_t)row * DM + lane * 8), a1 = *(const u32x4*)(xb + (size_t)row * DM + 512 + lane * 8);
        const u32x4 b0 = *(const u32x4*)(xb + (size_t)row2 * DM + lane * 8), b1 = *(const u32x4*)(xb + (size_t)row2 * DM + 512 + lane * 8);
        float s0 = (lane < 16) ? ssq[(size_t)row * 16 + lane] : 0.f, s1 = (lane < 16) ? ssq[(size_t)row2 * 16 + lane] : 0.f;
        s0 = wave_sum(s0); s1 = wave_sum(s1);
        const float r0 = __builtin_amdgcn_rsqf(s0 * (1.0f / DM) + EPSN), r1 = __builtin_amdgcn_rsqf(s1 * (1.0f / DM) + EPSN);
#define FN_OUT(A, R, ROW, OFF, G0, G1) do { f32x4 y0, y1; \
        y0[0] = __uint_as_float(A[0] << 16); y0[1] = __uint_as_float(A[0] & 0xffff0000u); y0[2] = __uint_as_float(A[1] << 16); y0[3] = __uint_as_float(A[1] & 0xffff0000u); \
        y1[0] = __uint_as_float(A[2] << 16); y1[1] = __uint_as_float(A[2] & 0xffff0000u); y1[2] = __uint_as_float(A[3] << 16); y1[3] = __uint_as_float(A[3] & 0xffff0000u); \
        *(f32x4*)(dst + (size_t)(ROW) * DM + (OFF)) = y0 * (R) * (G0); *(f32x4*)(dst + (size_t)(ROW) * DM + (OFF) + 4) = y1 * (R) * (G1); } while (0)
        FN_OUT(a0, r0, row, lane * 8, gv[0], gv[1]); FN_OUT(a1, r0, row, 512 + lane * 8, gv[2], gv[3]);
        if (row2 != row) { FN_OUT(b0, r1, row2, lane * 8, gv[0], gv[1]); FN_OUT(b1, r1, row2, 512 + lane * 8, gv[2], gv[3]); }
#undef FN_OUT
    }
}
__device__ __forceinline__ void shiftw_rows(const bf16_t* __restrict__ Wt, const float* __restrict__ mod, float* __restrict__ shw) {
    const int lane = threadIdx.x & 63, gw = blockIdx.x * 8 + (threadIdx.x >> 6), nw = gridDim.x * 8;
    for (int l = 0; l < 2; ++l) {
        f32x4 sh[8][4];
#pragma unroll
        for (int b = 0; b < 8; ++b) { const float* sp = mod + (size_t)(l * 9 + b) * 6144 + 3 * 1024 + lane * 8;
            sh[b][0] = *(const f32x4*)sp; sh[b][1] = *(const f32x4*)(sp + 4); sh[b][2] = *(const f32x4*)(sp + 512); sh[b][3] = *(const f32x4*)(sp + 516); }
        for (int n = gw; n < 2 * DFF; n += nw) {
            const bf16_t* wp = Wt + ((size_t)l * 2 * DFF + n) * DM + lane * 8;
            const u32x4 w0 = *(const u32x4*)wp, w1 = *(const u32x4*)(wp + 512);
            float wf[16];
#pragma unroll
            for (int q = 0; q < 4; ++q) { wf[2 * q] = __uint_as_float(w0[q] << 16); wf[2 * q + 1] = __uint_as_float(w0[q] & 0xffff0000u);
                                          wf[8 + 2 * q] = __uint_as_float(w1[q] << 16); wf[8 + 2 * q + 1] = __uint_as_float(w1[q] & 0xffff0000u); }
            float r[8];
#pragma unroll
            for (int b = 0; b < 8; ++b) { float s = 0.f;
#pragma unroll
                for (int q = 0; q < 4; ++q) s += (sh[b][q][0] * wf[4 * q] + sh[b][q][1] * wf[4 * q + 1]) + (sh[b][q][2] * wf[4 * q + 2] + sh[b][q][3] * wf[4 * q + 3]);
                r[b] = wave_sum(s); }
            if (lane < 8) { float v = r[0];
#pragma unroll
                for (int b = 1; b < 8; ++b) v = (lane == b) ? r[b] : v;
                shw[((size_t)l * 8 + lane) * (2 * DFF) + n] = v; }
        }
    }
}

constexpr int N_GEMV = 96, N_TR = 5120 / 4, N_FPOS = 0, N_CS = 4, N_ROPE = 1;
constexpr int IT_TR = N_GEMV, IT_FPOS = IT_TR + N_TR, IT_CS = IT_FPOS + N_FPOS, IT_ROPE = IT_CS + N_CS, N_ITEMS = IT_ROPE + N_ROPE;
__device__ __forceinline__ void phase_prep(const Params& p, LAS unsigned char* lds) {
    const int tid = threadIdx.x;
    unsigned char* ws = p.ws;
    LAS float* tab = (LAS float*)(lds + 114688);
    for (int i = tid; i < 4096; i += 512) tab[i] = __builtin_amdgcn_cosf((float)i * (1.0f / 4096.0f)) * (1.0f / 64.0f);
    __syncthreads();
    unsigned* qctr = (unsigned*)(p.ws + WS_BAR) + 4000;
    LAS int* qslot = (LAS int*)(lds + XLDS_OFF);
    for (int it = blockIdx.x; it < N_ITEMS; ) {
        if (it < IT_TR) {
            const int layer = it / 48, col0 = (it % 48) * 128;
            LAS float* sv = (LAS float*)lds; LAS float* red = (LAS float*)(lds + 36864);
            for (int i = tid; i < 9216; i += 512) { const int r = i >> 10, k = i & 1023; const float x = (r < 8) ? p.c[r * 1024 + k] : p.c_ctx[k]; sv[i] = x / (1.0f + __expf(-x)); }
            __syncthreads();
            const int kk = tid >> 5, c4 = tid & 31;
            const float* W = p.w_mod + (size_t)layer * 1024 * 6144 + col0 + c4 * 4;
            f32x4 acc[9];
#pragma unroll
            for (int r = 0; r < 9; ++r) acc[r] = (f32x4){0.f, 0.f, 0.f, 0.f};
#pragma unroll 4
            for (int i = 0; i < 64; ++i) { const int k = kk + 16 * i; const f32x4 w = *(const f32x4*)(W + (size_t)k * 6144);
#pragma unroll
                for (int r = 0; r < 9; ++r) acc[r] += w * sv[r * 1024 + k]; }
#pragma unroll
            for (int r = 0; r < 9; ++r) *(LAS f32x4*)(red + (kk * 9 + r) * 128 + c4 * 4) = acc[r];
            __syncthreads();
            float* mod = (float*)(ws + WS_MOD);
            for (int o = tid; o < 1152; o += 512) { const int r = o >> 7, ci = o & 127; float s = p.b_mod[layer * 6144 + col0 + ci];
                for (int q = 0; q < 16; ++q) s += red[(q * 9 + r) * 128 + ci];
                mod[(size_t)(layer * 9 + r) * 6144 + col0 + ci] = s; }
            __syncthreads();
        } else if (it < IT_FPOS) {
            LAS float* tile = (LAS float*)lds;
            const float* src; bf16_t* dst; int K, N, mode, t0;
#define TR_JOB(tt) do { int t = (tt); mode = 0; \
            if (t < 384) { src = p.w_qkv; dst = (bf16_t*)(ws + WS_WQKV); K = 1024; N = NQKV; mode = 1; } \
            else if (t < 640) { t -= 384; src = p.w_o; dst = (bf16_t*)(ws + WS_WO); K = 1024; N = 1024; } \
            else if (t < 896) { t -= 640; src = p.w_f; dst = (bf16_t*)(ws + WS_WF); K = 1024; N = 1024; } \
            else if (t < 2304) { t -= 896; src = p.w_gu; dst = (bf16_t*)(ws + WS_WGU); K = 1024; N = 2 * DFF; mode = 2; } \
            else if (t < 3712) { t -= 2304; src = p.w_gu + (size_t)1024 * 2 * DFF; dst = (bf16_t*)(ws + WS_WGU) + (size_t)2 * DFF * 1024; K = 1024; N = 2 * DFF; mode = 2; } \
            else if (t < 4416) { t -= 3712; src = p.w_d; dst = (bf16_t*)(ws + WS_WD); K = DFF; N = 1024; } \
            else { t -= 4416; src = p.w_d + (size_t)DFF * 1024; dst = (bf16_t*)(ws + WS_WD) + (size_t)1024 * DFF; K = DFF; N = 1024; } t0 = t; } while (0)
            TR_JOB((it - IT_TR) * 4);
            const int nkt = K / 64;
#pragma unroll
            for (int q = 0; q < 4; ++q) { const int t = t0 + q, kb = (t % nkt) * 64, n0 = (t / nkt) * 64;
                const int col = tid & 63, k0 = tid >> 6, np = n0 + col; int sc = np;
                if (mode == 1 && np < 1280) { const int i = np & 127; sc = (np & ~127) + (i >> 1) + 64 * (i & 1); }
                if (mode == 2) { const int r = np & 255, pn = np >> 8; sc = (r >> 7) * DFF + pn * 128 + (r & 127); }
#pragma unroll
                for (int i = 0; i < 8; ++i) { const int k = k0 + 8 * i; tile[q * 4160 + k * 65 + col] = src[(size_t)(kb + k) * N + sc]; } }
            __syncthreads();
#pragma unroll
            for (int q = 0; q < 4; ++q) { const int t = t0 + q, kb = (t % nkt) * 64, n0 = (t / nkt) * 64;
                const int nl = tid >> 3, ks = (tid & 7) * 8; float v[8];
#pragma unroll
                for (int j = 0; j < 8; ++j) v[j] = tile[q * 4160 + (ks + j) * 65 + nl];
                u32x4 w; w.x = cvtpk(v[0], v[1]); w.y = cvtpk(v[2], v[3]); w.z = cvtpk(v[4], v[5]); w.w = cvtpk(v[6], v[7]);
                *(u32x4*)(dst + (size_t)(n0 + nl) * K + kb + ks) = w; }
            __syncthreads();
#undef TR_JOB
        } else if (it < IT_ROPE) {
            const int q = it - IT_CS; bf16_t* CS = (bf16_t*)(ws + WS_CS);
            for (int s = 0; s < 8; ++s) { const int idx = s * 512 + tid, l = 64 * q + (idx >> 6), cc = (idx & 63) * 8, cs = cc >> 8, c0 = cc & 255; float v[8];
#pragma unroll
                for (int e = 0; e < 8; ++e) { const int m = (l * (c0 + e)) & 255; const int id = cs ? ((m * 16 - 1024) & 4095) : (m * 16); v[e] = 4.0f * tab[id]; }
                u32x4 w; w.x = cvtpk(v[0], v[1]); w.y = cvtpk(v[2], v[3]); w.z = cvtpk(v[4], v[5]); w.w = cvtpk(v[6], v[7]);
                *(u32x4*)(CS + (size_t)l * 512 + cc) = w; }
        } else {
            float* T = (float*)(ws + WS_ROPE);
            for (int i = tid; i < 2048; i += 512) { const int pos = i >> 5, f = i & 31;
                const float inv = __builtin_amdgcn_exp2f(-(float)f * (13.287712379549449f / 32.0f));
                const float ang = (float)pos * inv, rev = ang * 0.15915494309189535f, fr = rev - rintf(rev);
                T[2 * i] = __builtin_amdgcn_cosf(fr); T[2 * i + 1] = __builtin_amdgcn_sinf(fr); }
        }
        __syncthreads();
        if (tid == 0) *qslot = (int)gridDim.x + (int)__hip_atomic_fetch_add(qctr, 1u, __ATOMIC_RELAXED, __HIP_MEMORY_SCOPE_AGENT);
        __syncthreads();
        it = *qslot;
    }
}

#define XB_TMO      128
#define XB_XCNT(j)  (256  + 64 * (j))
#define XB_XSUB(j)  (1280 + 64 * (j))
#define XB_XGEN(j)  (2304 + 64 * (j))
#define XB_TOP      3328
#define XB_TOPGEN   3392
#define XB_SPIN_CAP (1u << 20)
__device__ __forceinline__ unsigned xb_ld(unsigned* p)              { return __hip_atomic_load(p, __ATOMIC_RELAXED, __HIP_MEMORY_SCOPE_AGENT); }
__device__ __forceinline__ unsigned xb_add(unsigned* p, unsigned v) { return __hip_atomic_fetch_add(p, v, __ATOMIC_RELAXED, __HIP_MEMORY_SCOPE_AGENT); }
__device__ __forceinline__ unsigned xb_xcc_id() { return (unsigned)__builtin_amdgcn_s_getreg((3 << 11) | 20) & 0xFu; }
#define XB_SPIN(cond, bar) do { unsigned _sp = 0; while (cond) { __builtin_amdgcn_s_sleep(1); \
    if ((++_sp & 255u) == 0u) { if (xb_ld(&(bar)[XB_TMO])) break; if (_sp > XB_SPIN_CAP) { atomicAdd(&(bar)[XB_TMO], 1u); break; } } } } while (0)
struct XcdBarrier { unsigned* bar; unsigned x; volatile LAS unsigned* st; };
__device__ __forceinline__ XcdBarrier xcd_barrier_post(unsigned* bar, volatile LAS unsigned* st) {
    XcdBarrier b; b.bar = bar; b.x = xb_xcc_id(); b.st = st;
    if (threadIdx.x == 0) (void)xb_add(&bar[XB_XCNT(b.x)], 1u);
    return b;
}
__device__ __forceinline__ void xcd_barrier_complete(unsigned* bar, unsigned x, unsigned& nloc, unsigned& nx) {
    const unsigned G = gridDim.x * gridDim.y * gridDim.z;
    unsigned sum, cnt, mine, sp = 0u;
    for (;;) {
        sum = 0u; cnt = 0u; mine = 0u;
#pragma unroll
        for (unsigned j = 0; j < 16; ++j) { const unsigned c = xb_ld(&bar[XB_XCNT(j)]); sum += c; cnt += (c > 0u) ? 1u : 0u; mine = (j == x) ? c : mine; }
        if (sum == G) break;
        __builtin_amdgcn_s_sleep(1);
        if ((++sp & 255u) == 0u) { if (xb_ld(&bar[XB_TMO])) break; if (sp > XB_SPIN_CAP) { atomicAdd(&bar[XB_TMO], 1u); break; } }
    }
    nloc = mine > 0u ? mine : 1u; nx = cnt > 0u ? cnt : 1u;
}
__device__ __forceinline__ void xcd_barrier(const XcdBarrier& b) {
    asm volatile("s_waitcnt vmcnt(0)" ::: "memory");
    __syncthreads();
    if (threadIdx.x == 0) {
        unsigned* bar = b.bar;
        __builtin_amdgcn_s_waitcnt(0);
        unsigned nloc = b.st[0], nx = b.st[1];
        if (nloc == 0u) { xcd_barrier_complete(bar, b.x, nloc, nx); b.st[0] = nloc; b.st[1] = nx; }
        const unsigned old = xb_add(&bar[XB_XSUB(b.x)], 1u);
        const unsigned gen = old / nloc;
        if (old + 1u == (gen + 1u) * nloc) {
            __builtin_amdgcn_fence(__ATOMIC_RELEASE, "agent");
            asm volatile("s_waitcnt vmcnt(0)" ::: "memory");
            const unsigned og = xb_add(&bar[XB_TOP], 1u);
            const unsigned tg = og / nx;
            if (og + 1u == (tg + 1u) * nx) xb_add(&bar[XB_TOPGEN], 1u);
            else XB_SPIN(xb_ld(&bar[XB_TOPGEN]) == tg, bar);
            __builtin_amdgcn_fence(__ATOMIC_ACQUIRE, "agent");
            xb_add(&bar[XB_XGEN(b.x)], 1u);
            asm volatile("s_waitcnt vmcnt(0)" ::: "memory");
        } else {
            XB_SPIN(xb_ld(&bar[XB_XGEN(b.x)]) == gen, bar);
            __builtin_amdgcn_fence(__ATOMIC_ACQUIRE, "agent");
            asm volatile("s_waitcnt vmcnt(0)" ::: "memory");
        }
    }
    __syncthreads();
}

constexpr int N_PHASES = 17;
__global__ void __launch_bounds__(512, 2) k_all(Params p, int ph_lo, int ph_hi) {
    extern __shared__ __attribute__((aligned(16))) unsigned char lds_raw[];
    LAS unsigned char* lds = (LAS unsigned char*)lds_raw;
    unsigned char* ws = p.ws;
    const int G = gridDim.x, c = blockIdx.x;
    bf16_t* X = (bf16_t*)(ws + WS_X); bf16_t* H = (bf16_t*)(ws + WS_H); const float* mod = (const float*)(ws + WS_MOD);
#define IN(k) (ph_lo <= (k) && (k) < ph_hi)
    volatile LAS unsigned* bst = (volatile LAS unsigned*)(lds + BARLDS_OFF);
    XcdBarrier xbar; xbar.bar = (unsigned*)(ws + WS_BAR); xbar.x = 0; xbar.st = bst;
    if (ph_hi - ph_lo > 1) {
        if (threadIdx.x == 0) { bst[0] = 0u; bst[1] = 0u; }
        __syncthreads();
        xbar = xcd_barrier_post((unsigned*)(ws + WS_BAR), bst);
    }
    if (ph_lo < 0) cg::this_grid().sync();
#define SEAM(k) do { if (IN(k) && IN((k) + 1)) xcd_barrier(xbar); } while (0)
    if (IN(0)) phase_prep(p, lds);
    SEAM(0);
    if (IN(1)) {
        normmod_rows(p.x, H, p.g_mix, mod, 0, MTOK, 12, 0);
        normmod_rows(p.ctx, H + (size_t)MTOK * DM, p.g_mix, mod, 0, MCTX, 30, 8);
        shiftw_rows((const bf16_t*)(ws + WS_WGU), mod, (float*)(ws + WS_SHW));
    }
    SEAM(1);
    if (IN(2)) {
        ProbPlain g{(const char*)H, (const char*)(ws + WS_WQKV), DM, DM, DM}; QkvOrder S{G, c};
        EpiQKV E{(bf16_t*)(ws + WS_Q), (bf16_t*)(ws + WS_K), (bf16_t*)(ws + WS_V), p.g_q, p.g_k, (const float*)(ws + WS_ROPE)};
        gemm_phase<EpiQKV, QkvOrder, ProbPlain>(lds, g, S, E);
    }
    SEAM(2);
    if (IN(3)) {
        const int vcu = (G % 8 == 0) ? (c % 8) * (G / 8) + c / 8 : c;
        const bf16_t* Q = (const bf16_t*)(ws + WS_Q); const bf16_t* Kc = (const bf16_t*)(ws + WS_K); const bf16_t* Vc = (const bf16_t*)(ws + WS_V); bf16_t* O = (bf16_t*)(ws + WS_O);
        float gqm = 0.f, gkm = 0.f;
        for (int i = 0; i < HD; ++i) { gqm = fmaxf(gqm, fabsf(p.g_q[i])); gkm = fmaxf(gkm, fabsf(p.g_k[i])); }
        const float mnC = -(SCALE * 1.4426950408889634f) * (float)HD * gqm * gkm;
        for (int v = vcu; v < NBATCH * NHEAD * (SEQ / 256); v += G) {
            const int grp = v >> 6, w = v & 63, b = grp >> 1, kvh = grp & 1, h = kvh * 4 + (w >> 4), qb = w & 15;
            const size_t qoff = ((size_t)(b * SEQ + qb * 256)) * DM + h * HD, koff = ((size_t)(b * NKVH + kvh) * SKV) * HD;
            attn_dense_body(Q + qoff, Kc + koff, Vc + koff, O + qoff, SKV, (char*)lds_raw, lds, mnC);
            __syncthreads();
        }
    }
    SEAM(3);
    if (IN(4)) {
        ProbPlain g{(const char*)(ws + WS_O), (const char*)(ws + WS_WO), DM, DM, DM}; StaticOrder S{MTOK / 256, DM / 256, G, c};
        EpiResB<true> E{p.x, X, mod + 2 * 1024, nullptr, H, (float*)(ws + WS_SSQ), p.g_ffn, mod + 4 * 1024};
        gemm_phase<EpiResB<true>, StaticOrder, ProbPlain>(lds, g, S, E);
    }
    SEAM(4);
    if (IN(5)) {
        ProbPlain g{(const char*)H, (const char*)(ws + WS_WGU), DM, DM, DM}; StaticOrder S{MTOK / 256, 2 * DFF / 256, G, c};
        EpiSwiGLU2 E{(bf16_t*)(ws + WS_ACT), (const float*)(ws + WS_SSQ), (const float*)(ws + WS_SHW)};
        rstd_prestep(S, (const float*)(ws + WS_SSQ), E.shw, (LAS float*)(lds + XLDS_OFF));
        gemm_phase<EpiSwiGLU2, StaticOrder, ProbPlain>(lds, g, S, E);
    }
    SEAM(5);
    if (IN(7)) {
        ProbPlain g{(const char*)(ws + WS_ACT), (const char*)(ws + WS_WD), DFF, DFF, DFF}; StaticOrder S{MTOK / 256, DM / 256, G, c};
        EpiResB<false> E{X, X, mod + 5 * 1024, nullptr, nullptr, (float*)(ws + WS_SSQ), nullptr, nullptr};
        gemm_phase<EpiResB<false>, StaticOrder, ProbPlain>(lds, g, S, E);
    }
    SEAM(7);
    if (IN(9)) phase_fft1(X, (const float*)(ws + WS_SSQ), p.g_mix + DM, mod + 9 * 6144, (bf16_t*)(ws + WS_AP), (char*)lds_raw);
    SEAM(9);
    if (IN(10)) phase_fft3((const bf16_t*)(ws + WS_AP), (bf16_t*)(ws + WS_Z), (char*)lds_raw);
    SEAM(10);
    if (IN(11)) {
        ProbCh g{(const char*)(ws + WS_Z), (const char*)(ws + WS_CS), 2048, 512, 512}; StaticOrder S{MTOK / 256, DM / 256, G, c};
        EpiBf16 E{H};
        gemm_phase<EpiBf16, StaticOrder, ProbCh>(lds, g, S, E);
    }
    SEAM(11);
    if (IN(12)) {
        ProbPlain g{(const char*)H, (const char*)(ws + WS_WF), DM, DM, DM}; StaticOrder S{MTOK / 256, DM / 256, G, c};
        EpiResB<false> E{X, X, mod + 9 * 6144 + 2 * 1024, p.b_f, (bf16_t*)(ws + WS_XG1), (float*)(ws + WS_SSQ), p.g_ffn + DM, mod + 9 * 6144 + 4 * 1024};
        gemm_phase<EpiResB<false>, StaticOrder, ProbPlain>(lds, g, S, E);
    }
    SEAM(12);
    if (IN(13)) {
        ProbPlain g{(const char*)(ws + WS_XG1), (const char*)(ws + WS_WGU) + (size_t)2 * DFF * DM * 2, DM, DM, DM}; StaticOrder S{MTOK / 256, 2 * DFF / 256, G, c};
        EpiSwiGLU2 E{(bf16_t*)(ws + WS_ACT), (const float*)(ws + WS_SSQ), (const float*)(ws + WS_SHW) + (size_t)8 * 2 * DFF};
        rstd_prestep(S, (const float*)(ws + WS_SSQ), E.shw, (LAS float*)(lds + XLDS_OFF));
        gemm_phase<EpiSwiGLU2, StaticOrder, ProbPlain>(lds, g, S, E);
    }
    SEAM(13);
    if (IN(15)) {
        ProbPlain g{(const char*)(ws + WS_ACT), (const char*)(ws + WS_WD) + (size_t)DM * DFF * 2, DFF, DFF, DFF}; StaticOrder S{MTOK / 256, DM / 256, G, c};
        EpiFinal E{X, mod + 9 * 6144 + 5 * 1024, p.g_final, p.out, (float*)(ws + WS_EXCH), (unsigned*)(ws + WS_BAR) + 3456};
        gemm_phase<EpiFinal, StaticOrder, ProbPlain>(lds, g, S, E);
    }
#undef IN
#undef SEAM
}

extern "C" void kernel_launch(void* const* d_in, const int* in_sizes, int n_in, void* d_out, int out_size, void* d_ws, size_t ws_size, hipStream_t stream) {
    static int grid = 0;
    if (grid == 0) {
        if (n_in != 17 || in_sizes[0] != MTOK * DM || out_size != MTOK * DM || ws_size < WS_END) {
            fprintf(stderr, "kernel_launch: shape/workspace mismatch: n_in %d in0 %d out %d ws %zu (need %zu)\n", n_in, n_in > 0 ? in_sizes[0] : -1, out_size, ws_size, (size_t)WS_END); grid = -1; return; }
        int dev = 0, cus = 0, per_cu = 0;
        if (hipGetDevice(&dev) != hipSuccess || hipDeviceGetAttribute(&cus, hipDeviceAttributeMultiprocessorCount, dev) != hipSuccess) { grid = -1; return; }
        if (hipFuncSetAttribute((const void*)k_all, hipFuncAttributeMaxDynamicSharedMemorySize, LDS_BYTES) != hipSuccess) { fprintf(stderr, "kernel_launch: hipFuncSetAttribute failed\n"); grid = -1; return; }
        if (hipOccupancyMaxActiveBlocksPerMultiprocessor(&per_cu, (const void*)k_all, 512, LDS_BYTES) != hipSuccess || per_cu < 1) { fprintf(stderr, "kernel_launch: occupancy query failed (%d)\n", per_cu); grid = -1; return; }
        grid = cus * per_cu;
    }
    if (grid < 0) return;
    Params p{};
    p.x = (const float*)d_in[0]; p.c = (const float*)d_in[1]; p.ctx = (const float*)d_in[2]; p.c_ctx = (const float*)d_in[3]; p.w_mod = (const float*)d_in[4]; p.b_mod = (const float*)d_in[5];
    p.g_mix = (const float*)d_in[6]; p.g_ffn = (const float*)d_in[7]; p.w_qkv = (const float*)d_in[8]; p.g_q = (const float*)d_in[9]; p.g_k = (const float*)d_in[10]; p.w_o = (const float*)d_in[11];
    p.w_f = (const float*)d_in[12]; p.b_f = (const float*)d_in[13]; p.w_gu = (const float*)d_in[14]; p.w_d = (const float*)d_in[15]; p.g_final = (const float*)d_in[16];
    p.out = (float*)d_out; p.ws = (unsigned char*)d_ws;
    if (hipMemsetAsync((unsigned char*)d_ws + WS_BAR, 0, BAR_BYTES, stream) != hipSuccess) { fprintf(stderr, "kernel_launch: memset of the barrier words failed\n"); return; }
#if MK_COOP
    int lo = 0, hi = N_PHASES;
    void* args[] = {&p, &lo, &hi};
    hipError_t e = hipLaunchCooperativeKernel((const void*)k_all, dim3(grid), dim3(512), args, LDS_BYTES, stream);
    if (e != hipSuccess) fprintf(stderr, "kernel_launch: cooperative launch failed: %s (grid %d)\n", hipGetErrorString(e), grid);
#else
    for (int ph = 0; ph < N_PHASES; ++ph) hipLaunchKernelGGL(k_all, dim3(grid), dim3(512), LDS_BYTES, stream, p, ph, ph + 1);
    hipError_t e = hipPeekAtLastError();
    if (e != hipSuccess) fprintf(stderr, "kernel_launch: launch failed: %s\n", hipGetErrorString(e));
#endif
}
```
